# Optimizing an MI355X kernel written in HIP

```python
import jax, jax.numpy as jnp
from jax import lax
import numpy as np

D_MODEL = 1024
BATCH = 8
SEQ = 4096
DEPTH = 1

GRID_W = 64
CTX_LEN = 256
EPS = 1e-6
ATTN_HEADS = 8
ATTN_KV_HEADS = 2
ATTN_HEAD_DIM = 64
ATTN_WIDTH = ATTN_HEADS * ATTN_HEAD_DIM
KV_WIDTH = ATTN_KV_HEADS * ATTN_HEAD_DIM
Q_BLOCK = 128
ROPE_THETA = 10000.0
HGRN_HEADS = 4
HGRN_HEAD_DIM = 128
HGRN_WIDTH = HGRN_HEADS * HGRN_HEAD_DIM
HGRN_CHUNK = 64
MIX_WIDTH = ATTN_WIDTH + HGRN_WIDTH
IN_PROJ_WIDTH = ATTN_WIDTH + 2 * KV_WIDTH + 5 * HGRN_WIDTH
N_GROUPS = 4
EXPERTS_PER_GROUP = 8
N_EXPERTS = N_GROUPS * EXPERTS_PER_GROUP
TOP_K = 2
EXPERT_FF = 512
MOE_BLOCK = 128

kernel_name = "hymba_style_gqa_hgrn2_hmoe_dit_layer"


def rms_norm(x, g):
    xf = x.astype(jnp.float32)
    y = xf * lax.rsqrt(jnp.mean(xf * xf, axis=-1, keepdims=True) + EPS)
    return (y * g.astype(jnp.float32)).astype(x.dtype)


def head_rms_norm(x, g, n_heads):
    shp = x.shape
    xf = x.astype(jnp.float32).reshape(shp[:-1] + (n_heads, shp[-1] // n_heads))
    xf = xf * lax.rsqrt(jnp.mean(xf * xf, axis=-1, keepdims=True) + EPS)
    return (xf.reshape(shp) * g.astype(jnp.float32)).astype(x.dtype)


def modulate(x, g, shift, scale):
    return rms_norm(x, g) * (1 + scale) + shift


def adaln(cond, w_ada, b_ada):
    m = jax.nn.silu(cond) @ w_ada + b_ada
    return jnp.split(m, 6, axis=-1)


def split_proj(p):
    points = []
    acc = 0
    for w in (ATTN_WIDTH, KV_WIDTH, KV_WIDTH, HGRN_WIDTH, HGRN_WIDTH, HGRN_WIDTH, HGRN_WIDTH):
        acc += w
        points.append(acc)
    return jnp.split(p, points, axis=-1)


def axial_rope_tables(n_tokens):
    rows = n_tokens // GRID_W
    row = jnp.repeat(jnp.arange(rows), GRID_W).astype(jnp.float32)
    col = jnp.tile(jnp.arange(GRID_W), rows).astype(jnp.float32)
    half = ATTN_HEAD_DIM // 2
    freqs = ROPE_THETA ** (-jnp.arange(0, half, 2, dtype=jnp.float32) / half)
    ang = jnp.stack([row[:, None] * freqs, col[:, None] * freqs], axis=1)
    return jnp.cos(ang), jnp.sin(ang)


def apply_rope(x, cos, sin):
    B, S, H, dh = x.shape
    xr = x.astype(jnp.float32).reshape(B, S, H, 2, dh // 4, 2)
    x1, x2 = xr[..., 0], xr[..., 1]
    c = cos[None, :, None]
    s = sin[None, :, None]
    out = jnp.stack([x1 * c - x2 * s, x1 * s + x2 * c], axis=-1)
    return out.reshape(B, S, H, dh).astype(x.dtype)


def attention_group(q_l, k_l, v_l, q_c, k_c, v_c, q_norm_g, k_norm_g, with_ctx):
    B, S, _ = q_l.shape
    L = q_c.shape[1]
    G = ATTN_HEADS // ATTN_KV_HEADS

    def heads(t, h):
        return t.reshape(t.shape[0], t.shape[1], h, ATTN_HEAD_DIM)

    cos, sin = axial_rope_tables(S)
    ql = apply_rope(rms_norm(heads(q_l, ATTN_HEADS), q_norm_g), cos, sin)
    kl = apply_rope(rms_norm(heads(k_l, ATTN_KV_HEADS), k_norm_g), cos, sin)
    vl = heads(v_l, ATTN_KV_HEADS)
    kc = rms_norm(heads(k_c, ATTN_KV_HEADS), k_norm_g)
    vc = heads(v_c, ATTN_KV_HEADS)
    scale = ATTN_HEAD_DIM ** -0.5
    k_all = jnp.concatenate([kc, kl], axis=1)
    v_all = jnp.concatenate([vc, vl], axis=1)

    def attend(q, k, v):
        s = jnp.einsum('bqkgd,bskd->bkgqs', q, k).astype(jnp.float32) * scale
        p = jax.nn.softmax(s, axis=-1).astype(v.dtype)
        return jnp.einsum('bkgqs,bskd->bqkgd', p, v)

    nb = S // Q_BLOCK
    qb = jnp.moveaxis(ql.reshape(B, nb, Q_BLOCK, ATTN_KV_HEADS, G, ATTN_HEAD_DIM), 1, 0)
    ob = lax.map(lambda q: attend(q, k_all, v_all), qb)
    o_l = jnp.moveaxis(ob, 0, 1).reshape(B, S, ATTN_WIDTH)
    o_c = None
    if with_ctx:
        qc = rms_norm(heads(q_c, ATTN_HEADS), q_norm_g)
        qc = qc.reshape(B, L, ATTN_KV_HEADS, G, ATTN_HEAD_DIM)
        o_c = attend(qc, kc, vc).reshape(B, L, ATTN_WIDTH)
    return o_l, o_c


def gla_scan(q, k, v, logf, s0):
    B, L, H, dk = q.shape
    dv = v.shape[-1]
    n = L // HGRN_CHUNK

    def chunks(t):
        return jnp.moveaxis(t.astype(jnp.float32).reshape(B, n, HGRN_CHUNK, H, t.shape[-1]), 1, 0)

    causal = jnp.tril(jnp.ones((HGRN_CHUNK, HGRN_CHUNK), dtype=bool))[None, :, :, None, None]

    def step(S, inp):
        qc, kc, vc, gc = inp
        b = jnp.cumsum(gc, axis=1)
        inter = jnp.einsum('bthd,bhdv->bthv', qc * jnp.exp(b), S)
        decay = jnp.exp(jnp.where(causal, b[:, :, None] - b[:, None, :], -jnp.inf))
        A = jnp.einsum('bthd,bshd,btshd->bhts', qc, kc, decay)
        intra = jnp.einsum('bhts,bshv->bthv', A, vc)
        b_end = b[:, -1]
        S_new = jnp.exp(b_end)[..., None] * S + jnp.einsum(
            'bshd,bshv->bhdv', kc * jnp.exp(b_end[:, None] - b), vc)
        return S_new, inter + intra

    S, o = lax.scan(step, s0, (chunks(q), chunks(k), chunks(v), chunks(logf)))
    return S, jnp.moveaxis(o, 0, 1).reshape(B, L, H, dv)


def hgrn2_group(lat, ctx, lb):
    def heads(t):
        return t.reshape(t.shape[0], t.shape[1], HGRN_HEADS, HGRN_HEAD_DIM)

    def prep(q, ff, fb, i):
        q = jax.nn.silu(q.astype(jnp.float32)) * (HGRN_HEAD_DIM ** -0.5)

        def gate(fr, lbd):
            f = lbd + (1 - lbd) * jax.nn.sigmoid(fr.astype(jnp.float32))
            return heads(1 - f), heads(jnp.log(f))

        return heads(q), heads(i), gate(ff, lb[0]), gate(fb, lb[1])

    qc, ic, (kcf, gcf), (kcb, gcb) = prep(*ctx)
    ql, il, (klf, glf), (klb, glb) = prep(*lat)
    B = ql.shape[0]
    s0 = jnp.zeros((B, HGRN_HEADS, HGRN_HEAD_DIM, HGRN_HEAD_DIM), jnp.float32)

    def flip(t):
        return jnp.flip(t, axis=1)

    s_cf, o_cf = gla_scan(qc, kcf, ic, gcf, s0)
    s_cb, o_cb = gla_scan(flip(qc), flip(kcb), flip(ic), flip(gcb), s0)
    _, o_lf = gla_scan(ql, klf, il, glf, s_cf)
    _, o_lb = gla_scan(flip(ql), flip(klb), flip(il), flip(glb), s_cb)
    o_l = o_lf + flip(o_lb)
    o_c = o_cf + flip(o_cb)
    return (o_l.reshape(o_l.shape[0], o_l.shape[1], HGRN_WIDTH),
            o_c.reshape(o_c.shape[0], o_c.shape[1], HGRN_WIDTH))


def mixing(h, hc, w_in, q_norm_g, k_norm_g, attn_out_g, lb, hgrn_out_g, w_out, with_ctx):
    qa, ka, va, qr, ffr, fbr, ir, gr = split_proj(h @ w_in)
    qac, kac, vac, qrc, ffrc, fbrc, irc, grc = split_proj(hc @ w_in)
    oa, oac = attention_group(qa, ka, va, qac, kac, vac, q_norm_g, k_norm_g, with_ctx)
    orl, orc = hgrn2_group((qr, ffr, fbr, ir), (qrc, ffrc, fbrc, irc), lb)
    oa = head_rms_norm(oa, attn_out_g, ATTN_HEADS)
    orl = (head_rms_norm(orl, hgrn_out_g, HGRN_HEADS) * jax.nn.silu(gr)).astype(h.dtype)
    mix_l = jnp.concatenate([oa, orl], axis=-1) @ w_out
    mix_c = None
    if with_ctx:
        oac = head_rms_norm(oac, attn_out_g, ATTN_HEADS)
        orc = (head_rms_norm(orc, hgrn_out_g, HGRN_HEADS) * jax.nn.silu(grc)).astype(hc.dtype)
        mix_c = jnp.concatenate([oac, orc], axis=-1) @ w_out
    return mix_l, mix_c


def moe_ffn(h, w_router_grp, b_router_grp, w_router_exp, b_router_exp, w_exp_gate, w_exp_up, w_exp_down):
    N, D = h.shape
    pg = jax.nn.softmax((h @ w_router_grp).astype(jnp.float32) + b_router_grp, axis=-1)
    pg_top, g_sel = lax.top_k(pg, 1)
    le = ((h @ w_router_exp).astype(jnp.float32) + b_router_exp).reshape(N, N_GROUPS, EXPERTS_PER_GROUP)
    le = jnp.take_along_axis(le, g_sel[:, :, None], axis=1)[:, 0]
    pe = jax.nn.softmax(le, axis=-1)
    pe_top, e_loc = lax.top_k(pe, TOP_K)
    w = pg_top * pe_top / jnp.sum(pe_top, axis=-1, keepdims=True)
    e_id = g_sel * EXPERTS_PER_GROUP + e_loc

    A = N * TOP_K
    e_flat = e_id.reshape(-1)
    tok = jnp.repeat(jnp.arange(N, dtype=jnp.int32), TOP_K)
    w_flat = w.reshape(-1)
    order = jnp.argsort(e_flat)
    e_s, tok_s, w_s = e_flat[order], tok[order], w_flat[order]
    counts = jnp.bincount(e_flat, length=N_EXPERTS)
    padded = (counts + MOE_BLOCK - 1) // MOE_BLOCK * MOE_BLOCK
    start = jnp.cumsum(counts) - counts
    pend = jnp.cumsum(padded)
    pstart = pend - padded
    dest = pstart[e_s] + (jnp.arange(A, dtype=jnp.int32) - start[e_s])
    cap = -(-A // MOE_BLOCK) * MOE_BLOCK + N_EXPERTS * MOE_BLOCK
    n_blk = cap // MOE_BLOCK
    slot_tok = jnp.zeros((cap,), jnp.int32).at[dest].set(tok_s)
    slot_w = jnp.zeros((cap,), jnp.float32).at[dest].set(w_s)
    blk_start = jnp.arange(n_blk, dtype=jnp.int32) * MOE_BLOCK
    blk_e = jnp.minimum(jnp.sum(blk_start[:, None] >= pend[None, :], axis=1), N_EXPERTS - 1)
    xs = h[slot_tok].reshape(n_blk, MOE_BLOCK, D)

    def expert_block(args):
        xb, e = args
        a = jax.nn.silu(xb @ w_exp_gate[e]) * (xb @ w_exp_up[e])
        return a @ w_exp_down[e]

    ys = lax.map(expert_block, (xs, blk_e)).reshape(cap, D)
    out = jnp.zeros((N, D), jnp.float32).at[slot_tok].add(ys.astype(jnp.float32) * slot_w[:, None])
    return out.astype(h.dtype)


def trunk_layer(x, xc, c, c_ctx, w_ada, b_ada, norm1_g, norm2_g, w_in, q_norm_g, k_norm_g,
                attn_out_g, lb, hgrn_out_g, w_out, w_router_grp, b_router_grp, w_router_exp,
                b_router_exp, w_exp_gate, w_exp_up, w_exp_down, with_ctx):
    B, S, D = x.shape
    sh1, sc1, gt1, sh2, sc2, gt2 = adaln(c, w_ada, b_ada)
    csh1, csc1, cgt1, csh2, csc2, cgt2 = adaln(c_ctx, w_ada, b_ada)
    h = modulate(x, norm1_g, sh1[:, None], sc1[:, None])
    hc = modulate(xc, norm1_g, csh1, csc1)
    mix_l, mix_c = mixing(h, hc, w_in, q_norm_g, k_norm_g, attn_out_g, lb, hgrn_out_g, w_out, with_ctx)
    moe_args = (w_router_grp, b_router_grp, w_router_exp, b_router_exp, w_exp_gate, w_exp_up, w_exp_down)
    x = x + gt1[:, None] * mix_l
    h2 = modulate(x, norm2_g, sh2[:, None], sc2[:, None])
    x = x + gt2[:, None] * moe_ffn(h2.reshape(B * S, D), *moe_args).reshape(B, S, D)
    if with_ctx:
        xc = xc + cgt1 * mix_c
        h2c = modulate(xc, norm2_g, csh2, csc2)
        xc = xc + cgt2 * moe_ffn(h2c.reshape(-1, D), *moe_args).reshape(xc.shape)
    return x, xc


def setup_inputs(seed: int = 0) -> dict:
    key = jax.random.key(seed)
    ks = jax.random.split(key, 22)
    f32 = jnp.float32
    D = D_MODEL

    def nrm(k, shape, s):
        return jax.random.normal(k, shape, f32) * s

    return {
        "x": nrm(ks[0], (BATCH, SEQ, D), 1.0),
        "c": nrm(ks[1], (BATCH, D), 1.0),
        "ctx": nrm(ks[2], (BATCH, CTX_LEN, D), 1.0),
        "c_ctx": nrm(ks[3], (D,), 1.0),
        "w_ada": nrm(ks[4], (DEPTH, D, 6 * D), 0.5 * D ** -0.5),
        "b_ada": nrm(ks[5], (DEPTH, 6 * D), 0.01),
        "norm1_g": 1.0 + nrm(ks[6], (DEPTH, D), 0.1),
        "norm2_g": 1.0 + nrm(ks[7], (DEPTH, D), 0.1),
        "w_in": nrm(ks[8], (DEPTH, D, IN_PROJ_WIDTH), D ** -0.5),
        "q_norm_g": 1.0 + nrm(ks[9], (DEPTH, ATTN_HEAD_DIM), 0.1),
        "k_norm_g": 1.0 + nrm(ks[10], (DEPTH, ATTN_HEAD_DIM), 0.1),
        "attn_out_g": 1.0 + nrm(ks[11], (DEPTH, ATTN_WIDTH), 0.1),
        "hgrn_lb": nrm(ks[12], (2, DEPTH + 1, HGRN_WIDTH), 0.5),
        "hgrn_out_g": 1.0 + nrm(ks[13], (DEPTH, HGRN_WIDTH), 0.1),
        "w_out": nrm(ks[14], (DEPTH, MIX_WIDTH, D), MIX_WIDTH ** -0.5),
        "w_router_grp": nrm(ks[15], (DEPTH, D, N_GROUPS), D ** -0.5),
        "b_router_grp": nrm(ks[16], (DEPTH, N_GROUPS), 0.01),
        "w_router_exp": nrm(ks[17], (DEPTH, D, N_EXPERTS), D ** -0.5),
        "b_router_exp": nrm(ks[18], (DEPTH, N_EXPERTS), 0.01),
        "w_exp_gate": nrm(ks[19], (DEPTH, N_EXPERTS, D, EXPERT_FF), D ** -0.5),
        "w_exp_up": nrm(ks[20], (DEPTH, N_EXPERTS, D, EXPERT_FF), D ** -0.5),
        "w_exp_down": nrm(ks[21], (DEPTH, N_EXPERTS, EXPERT_FF, D), EXPERT_FF ** -0.5),
    }


def reference(x, c, ctx, c_ctx, w_ada, b_ada, norm1_g, norm2_g, w_in, q_norm_g, k_norm_g,
              attn_out_g, hgrn_lb, hgrn_out_g, w_out, w_router_grp, b_router_grp, w_router_exp,
              b_router_exp, w_exp_gate, w_exp_up, w_exp_down):
    lb_all = jnp.cumsum(jax.nn.softmax(hgrn_lb.astype(jnp.float32), axis=1), axis=1)
    xc = ctx
    for layer in range(DEPTH):
        x, xc = trunk_layer(
            x, xc, c, c_ctx, w_ada[layer], b_ada[layer], norm1_g[layer], norm2_g[layer],
            w_in[layer], q_norm_g[layer], k_norm_g[layer], attn_out_g[layer], lb_all[:, layer],
            hgrn_out_g[layer], w_out[layer], w_router_grp[layer], b_router_grp[layer],
            w_router_exp[layer], b_router_exp[layer], w_exp_gate[layer], w_exp_up[layer],
            w_exp_down[layer], with_ctx=layer < DEPTH - 1)
    return x
```

```cpp
#include <hip/hip_runtime.h>
#include <cstdio>
#include <cstdint>

typedef unsigned short bf16_t;
__device__ __forceinline__ float bf2f(bf16_t v) { return __uint_as_float(((unsigned)v) << 16); }
__device__ __forceinline__ bf16_t f2bf(float f) { unsigned u = __float_as_uint(f); return (bf16_t)((u + 0x7fffu + ((u >> 16) & 1u)) >> 16); }

constexpr int D = 1024, NB = 8, SEQ = 4096, CTX = 256, TPB = SEQ + CTX;
constexpr int NROW = NB * TPB;
constexpr int NLAT = NB * SEQ;
constexpr int PW = 3328;
constexpr int C_QA = 0, C_KA = 512, C_VA = 640, C_QR = 768, C_FF = 1280, C_FB = 1792, C_IR = 2304, C_GR = 2816;
constexpr int NEXP = 32, FFE = 512;
constexpr float EPS = 1e-6f;
constexpr int LISTCAP = NLAT;
constexpr int MAXTILES = 65536 / 64 + 32;

constexpr size_t MiB = 1ull << 20;
constexpr size_t WS_CTL = 0;
constexpr size_t WS_MOD = 1 * MiB;
constexpr size_t WS_H = 2 * MiB;
constexpr size_t WS_P = 70 * MiB;
constexpr size_t WS_OA = 291 * MiB;
constexpr size_t WS_ORF = 323 * MiB, WS_ORB = 355 * MiB;
constexpr size_t WS_H2 = 387 * MiB;
constexpr size_t WS_RT = 451 * MiB;
constexpr size_t WS_MIX = WS_P;
constexpr size_t WS_ACT = WS_P + 128 * MiB;
constexpr size_t WS_YS = WS_H;

constexpr int CT_CNT = 0, CT_NT = 32, CT_TE = 64, CT_TI = CT_TE + MAXTILES, CT_TS = CT_TI + MAXTILES;

__device__ __forceinline__ float siluf(float v) { return v / (1.f + __expf(-v)); }
__device__ __forceinline__ float wave_sum(float v) {
#pragma unroll
    for (int o = 32; o >= 1; o >>= 1) v += __shfl_xor(v, o);
    return v;
}
__device__ __forceinline__ float half_sum(float v) {
#pragma unroll
    for (int o = 16; o >= 1; o >>= 1) v += __shfl_xor(v, o);
    return v;
}

__global__ void __launch_bounds__(256) k_adaln(const float* __restrict__ c, const float* __restrict__ c_ctx, const float* __restrict__ w_ada,
                                               const float* __restrict__ b_ada, const float* __restrict__ hgrn_lb, float* mod, float* lb) {
    __shared__ float s[9][1024];
    const int tid = threadIdx.x;
    for (int i = tid; i < 9 * 1024; i += 256) { const int r = i >> 10, k = i & 1023; const float v = r < 8 ? c[r * 1024 + k] : c_ctx[k]; s[r][k] = v / (1.f + expf(-v)); }
    __syncthreads();
    const int j = blockIdx.x * 256 + tid;
    float acc[9];
#pragma unroll
    for (int r = 0; r < 9; ++r) acc[r] = b_ada[j];
    for (int k = 0; k < 1024; ++k) {
        const float w = w_ada[(size_t)k * 6144 + j];
#pragma unroll
        for (int r = 0; r < 9; ++r) acc[r] += s[r][k] * w;
    }
#pragma unroll
    for (int r = 0; r < 9; ++r) mod[r * 6144 + j] = acc[r];
    if (blockIdx.x == 0) {
        for (int i = tid; i < 1024; i += 256) { const int d = i >> 9, w = i & 511; const float l0 = hgrn_lb[(d * 2 + 0) * 512 + w], l1 = hgrn_lb[(d * 2 + 1) * 512 + w]; lb[i] = 1.f / (1.f + expf(l1 - l0)); }
    }
}

__global__ void __launch_bounds__(256) k_modulate1(const float* __restrict__ x, const float* __restrict__ ctx, const float* __restrict__ g1, const float* __restrict__ mod, bf16_t* H) {
    __shared__ float red[4];
    const int row = blockIdx.x, tid = threadIdx.x, b = row / TPB, pos = row % TPB;
    const float* src = pos < CTX ? ctx + ((size_t)b * CTX + pos) * D : x + ((size_t)b * SEQ + (pos - CTX)) * D;
    const float* m = mod + (pos < CTX ? 8 : b) * 6144;
    const float4 v = *(const float4*)(src + tid * 4);
    float ss = v.x * v.x + v.y * v.y + v.z * v.z + v.w * v.w;
    ss = wave_sum(ss);
    if ((tid & 63) == 0) red[tid >> 6] = ss;
    __syncthreads();
    const float rstd = rsqrtf((red[0] + red[1] + red[2] + red[3]) * (1.f / D) + EPS);
    const int k = tid * 4;
    const float vv[4] = {v.x, v.y, v.z, v.w};
    bf16_t o[4];
#pragma unroll
    for (int i = 0; i < 4; ++i) o[i] = f2bf(vv[i] * rstd * g1[k + i] * (1.f + m[1024 + k + i]) + m[k + i]);
    uint2 pk; pk.x = o[0] | ((unsigned)o[1] << 16); pk.y = o[2] | ((unsigned)o[3] << 16);
    *(uint2*)(H + (size_t)row * D + k) = pk;
}

struct GemmArgs {
    const bf16_t* A; const float* W; const float* W2; void* out; const int* ctl; const int* list; const float* ew; int K; int ldw; int pad; int pad2;
};
template <int MODE> __global__ void __launch_bounds__(256) k_gemm(GemmArgs a) {
    __shared__ __attribute__((aligned(16))) float As[16][68];
    __shared__ __attribute__((aligned(16))) float Bs[16][64];
    __shared__ __attribute__((aligned(16))) float Bs2[MODE == 2 ? 16 : 1][64];
    const int tid = threadIdx.x, ty = tid >> 4, tx = tid & 15;
    const int n0 = blockIdx.x * 64;
    int m0 = blockIdx.y * 64;
    const float* W = a.W; const float* W2 = a.W2;
    int e = 0, i0 = 0, slot0 = 0, cnt = 0;
    if (MODE >= 2) {
        const int ti = blockIdx.y;
        if (ti >= a.ctl[CT_NT]) return;
        e = a.ctl[CT_TE + ti]; i0 = a.ctl[CT_TI + ti]; slot0 = a.ctl[CT_TS + ti]; cnt = a.ctl[CT_CNT + e];
        if (MODE == 2) { W += (size_t)e * 1024 * 512; W2 += (size_t)e * 1024 * 512; }
        else W += (size_t)e * 512 * 1024;
    }
    const int arow = tid >> 2, ak = (tid & 3) * 4;
    const bf16_t* ap = nullptr;
    if (MODE == 0 || MODE == 1) ap = a.A + (size_t)(m0 + arow) * a.K;
    else if (MODE == 2) { const int i = i0 + arow; if (i < cnt) ap = a.A + (size_t)(a.list[e * LISTCAP + i] >> 1) * 1024; }
    else ap = a.A + (size_t)(slot0 + arow) * 512;
    const int bk = tid >> 4, bn = (tid & 15) * 4;
    float acc[4][4], acc2[4][4];
#pragma unroll
    for (int i = 0; i < 4; ++i)
#pragma unroll
        for (int j = 0; j < 4; ++j) { acc[i][j] = 0.f; acc2[i][j] = 0.f; }
    for (int k0 = 0; k0 < a.K; k0 += 16) {
        uint2 av = make_uint2(0u, 0u);
        if (ap) av = *(const uint2*)(ap + k0 + ak);
        const float4 bv = *(const float4*)(W + (size_t)(k0 + bk) * a.ldw + n0 + bn);
        float4 bv2 = make_float4(0.f, 0.f, 0.f, 0.f);
        if (MODE == 2) bv2 = *(const float4*)(W2 + (size_t)(k0 + bk) * a.ldw + n0 + bn);
        __syncthreads();
        As[ak + 0][arow] = __uint_as_float(av.x << 16); As[ak + 1][arow] = __uint_as_float(av.x & 0xffff0000u);
        As[ak + 2][arow] = __uint_as_float(av.y << 16); As[ak + 3][arow] = __uint_as_float(av.y & 0xffff0000u);
        *(float4*)&Bs[bk][bn] = bv;
        if (MODE == 2) *(float4*)&Bs2[bk][bn] = bv2;
        __syncthreads();
#pragma unroll
        for (int kk = 0; kk < 16; ++kk) {
            const float4 a4 = *(const float4*)&As[kk][ty * 4];
            const float4 b4 = *(const float4*)&Bs[kk][tx * 4];
            const float aa[4] = {a4.x, a4.y, a4.z, a4.w}, bb[4] = {b4.x, b4.y, b4.z, b4.w};
#pragma unroll
            for (int i = 0; i < 4; ++i)
#pragma unroll
                for (int j = 0; j < 4; ++j) acc[i][j] += aa[i] * bb[j];
            if (MODE == 2) {
                const float4 c4 = *(const float4*)&Bs2[kk][tx * 4];
                const float cc[4] = {c4.x, c4.y, c4.z, c4.w};
#pragma unroll
                for (int i = 0; i < 4; ++i)
#pragma unroll
                    for (int j = 0; j < 4; ++j) acc2[i][j] += aa[i] * cc[j];
            }
        }
    }
#pragma unroll
    for (int i = 0; i < 4; ++i) {
        const int r = ty * 4 + i, n = n0 + tx * 4;
        if (MODE == 0) {
            bf16_t* o = (bf16_t*)a.out + (size_t)(m0 + r) * PW + n;
            uint2 pk; pk.x = f2bf(acc[i][0]) | ((unsigned)f2bf(acc[i][1]) << 16); pk.y = f2bf(acc[i][2]) | ((unsigned)f2bf(acc[i][3]) << 16);
            *(uint2*)o = pk;
        } else if (MODE == 1) {
            float* o = (float*)a.out + (size_t)(m0 + r) * 1024 + n;
            *(float4*)o = make_float4(acc[i][0], acc[i][1], acc[i][2], acc[i][3]);
        } else if (MODE == 2) {
            bf16_t* o = (bf16_t*)a.out + (size_t)(slot0 + r) * 512 + n;
            float v[4];
#pragma unroll
            for (int j = 0; j < 4; ++j) { const float g = acc[i][j]; v[j] = g / (1.f + expf(-g)) * acc2[i][j]; }
            uint2 pk; pk.x = f2bf(v[0]) | ((unsigned)f2bf(v[1]) << 16); pk.y = f2bf(v[2]) | ((unsigned)f2bf(v[3]) << 16);
            *(uint2*)o = pk;
        } else {
            const int ii = i0 + r;
            if (ii < cnt) {
                const int tok2 = a.list[e * LISTCAP + ii];
                const float w = a.ew[tok2];
                bf16_t* o = (bf16_t*)a.out + (size_t)tok2 * 1024 + n;
                uint2 pk; pk.x = f2bf(acc[i][0] * w) | ((unsigned)f2bf(acc[i][1] * w) << 16); pk.y = f2bf(acc[i][2] * w) | ((unsigned)f2bf(acc[i][3] * w) << 16);
                *(uint2*)o = pk;
            }
        }
    }
}

__global__ void __launch_bounds__(256) k_post(bf16_t* P, const float* __restrict__ qg, const float* __restrict__ kg, const float* __restrict__ lb) {
    const int row = blockIdx.x, tid = threadIdx.x, pos = row % TPB;
    const bool lat = pos >= CTX;
    bf16_t* p = P + (size_t)row * PW;
    const int t = pos - CTX, ri = t >> 6, ci = t & 63;
    const int l32 = tid & 31, half = l32 >> 4, f = l32 & 15;
    float cs = 1.f, sn = 0.f;
    if (lat) { const float freq = powf(10000.0f, -(float)f / 16.0f); const float ang = (float)(half == 0 ? ri : ci) * freq; cs = cosf(ang); sn = sinf(ang); }
    if (lat) {
        const unsigned u = *(const unsigned*)(p + C_QA + 2 * tid);
        float x1 = __uint_as_float(u << 16), x2 = __uint_as_float(u & 0xffff0000u);
        const float ss = half_sum(x1 * x1 + x2 * x2);
        const float rstd = rsqrtf(ss * (1.f / 64.f) + EPS);
        x1 = x1 * rstd * qg[2 * l32]; x2 = x2 * rstd * qg[2 * l32 + 1];
        const float y1 = x1 * cs - x2 * sn, y2 = x1 * sn + x2 * cs;
        *(unsigned*)(p + C_QA + 2 * tid) = f2bf(y1) | ((unsigned)f2bf(y2) << 16);
    }
    if (tid < 64) {
        const unsigned u = *(const unsigned*)(p + C_KA + 2 * tid);
        float x1 = __uint_as_float(u << 16), x2 = __uint_as_float(u & 0xffff0000u);
        const float ss = half_sum(x1 * x1 + x2 * x2);
        const float rstd = rsqrtf(ss * (1.f / 64.f) + EPS);
        x1 = x1 * rstd * kg[2 * l32]; x2 = x2 * rstd * kg[2 * l32 + 1];
        const float y1 = x1 * cs - x2 * sn, y2 = x1 * sn + x2 * cs;
        *(unsigned*)(p + C_KA + 2 * tid) = f2bf(y1) | ((unsigned)f2bf(y2) << 16);
    }
    {
        const unsigned u = *(const unsigned*)(p + C_QR + 2 * tid);
        const float x1 = __uint_as_float(u << 16), x2 = __uint_as_float(u & 0xffff0000u);
        const float sc = 0.08838834764831845f;
        *(unsigned*)(p + C_QR + 2 * tid) = f2bf(x1 / (1.f + expf(-x1)) * sc) | ((unsigned)f2bf(x2 / (1.f + expf(-x2)) * sc) << 16);
    }
#pragma unroll
    for (int dir = 0; dir < 2; ++dir) {
        const int c0 = dir == 0 ? C_FF : C_FB;
        const unsigned u = *(const unsigned*)(p + c0 + 2 * tid);
        const float x1 = __uint_as_float(u << 16), x2 = __uint_as_float(u & 0xffff0000u);
        const float l1 = lb[dir * 512 + 2 * tid], l2 = lb[dir * 512 + 2 * tid + 1];
        const float f1 = l1 + (1.f - l1) / (1.f + expf(-x1)), f2 = l2 + (1.f - l2) / (1.f + expf(-x2));
        *(unsigned*)(p + c0 + 2 * tid) = f2bf(logf(f1)) | ((unsigned)f2bf(logf(f2)) << 16);
    }
    {
        const unsigned u = *(const unsigned*)(p + C_GR + 2 * tid);
        const float x1 = __uint_as_float(u << 16), x2 = __uint_as_float(u & 0xffff0000u);
        *(unsigned*)(p + C_GR + 2 * tid) = f2bf(x1 / (1.f + expf(-x1))) | ((unsigned)f2bf(x2 / (1.f + expf(-x2))) << 16);
    }
}

__global__ void __launch_bounds__(256) k_attn_naive(const bf16_t* __restrict__ P, bf16_t* OA) {
    const int blk = blockIdx.x, qb = blk & 15, h = (blk >> 4) & 7, b = blk >> 7, tid = threadIdx.x;
    const int t = qb * 256 + tid, kvh = h >> 2;
    const bf16_t* qp = P + (size_t)(b * TPB + CTX + t) * PW + C_QA + h * 64;
    float q[64];
#pragma unroll
    for (int d8 = 0; d8 < 8; ++d8) {
        const uint4 u = *(const uint4*)(qp + d8 * 8);
        const unsigned w[4] = {u.x, u.y, u.z, u.w};
#pragma unroll
        for (int i = 0; i < 4; ++i) { q[d8 * 8 + 2 * i] = __uint_as_float(w[i] << 16) * 0.125f; q[d8 * 8 + 2 * i + 1] = __uint_as_float(w[i] & 0xffff0000u) * 0.125f; }
    }
    const bf16_t* Kb = P + (size_t)(b * TPB) * PW + C_KA + kvh * 64;
    const bf16_t* Vb = P + (size_t)(b * TPB) * PW + C_VA + kvh * 64;
    float m = -1e30f;
    for (int j = 0; j < TPB; ++j) {
        const bf16_t* kr = Kb + (size_t)j * PW;
        float s = 0.f;
#pragma unroll
        for (int d8 = 0; d8 < 8; ++d8) {
            const uint4 u = *(const uint4*)(kr + d8 * 8);
            const unsigned w[4] = {u.x, u.y, u.z, u.w};
#pragma unroll
            for (int i = 0; i < 4; ++i) { s += q[d8 * 8 + 2 * i] * __uint_as_float(w[i] << 16); s += q[d8 * 8 + 2 * i + 1] * __uint_as_float(w[i] & 0xffff0000u); }
        }
        m = fmaxf(m, s);
    }
    float l = 0.f, o[64];
#pragma unroll
    for (int d = 0; d < 64; ++d) o[d] = 0.f;
    for (int j = 0; j < TPB; ++j) {
        const bf16_t* kr = Kb + (size_t)j * PW;
        const bf16_t* vr = Vb + (size_t)j * PW;
        float s = 0.f;
#pragma unroll
        for (int d8 = 0; d8 < 8; ++d8) {
            const uint4 u = *(const uint4*)(kr + d8 * 8);
            const unsigned w[4] = {u.x, u.y, u.z, u.w};
#pragma unroll
            for (int i = 0; i < 4; ++i) { s += q[d8 * 8 + 2 * i] * __uint_as_float(w[i] << 16); s += q[d8 * 8 + 2 * i + 1] * __uint_as_float(w[i] & 0xffff0000u); }
        }
        const float p = __expf(s - m);
        l += p;
#pragma unroll
        for (int d8 = 0; d8 < 8; ++d8) {
            const uint4 u = *(const uint4*)(vr + d8 * 8);
            const unsigned w[4] = {u.x, u.y, u.z, u.w};
#pragma unroll
            for (int i = 0; i < 4; ++i) { o[d8 * 8 + 2 * i] += p * __uint_as_float(w[i] << 16); o[d8 * 8 + 2 * i + 1] += p * __uint_as_float(w[i] & 0xffff0000u); }
        }
    }
    const float rl = 1.f / l;
    bf16_t* op = OA + (size_t)(b * SEQ + t) * 512 + h * 64;
#pragma unroll
    for (int d8 = 0; d8 < 8; ++d8) {
        uint4 u;
        u.x = f2bf(o[d8 * 8 + 0] * rl) | ((unsigned)f2bf(o[d8 * 8 + 1] * rl) << 16);
        u.y = f2bf(o[d8 * 8 + 2] * rl) | ((unsigned)f2bf(o[d8 * 8 + 3] * rl) << 16);
        u.z = f2bf(o[d8 * 8 + 4] * rl) | ((unsigned)f2bf(o[d8 * 8 + 5] * rl) << 16);
        u.w = f2bf(o[d8 * 8 + 6] * rl) | ((unsigned)f2bf(o[d8 * 8 + 7] * rl) << 16);
        *(uint4*)(op + d8 * 8) = u;
    }
}

__device__ __forceinline__ int hg_pos(int dir, int n) { return dir == 0 ? n : (n < CTX ? CTX - 1 - n : (TPB + CTX - 1) - n); }
__global__ void __launch_bounds__(64) k_hgrn_naive(const bf16_t* __restrict__ P, bf16_t* ORF, bf16_t* ORB) {
    const int blk = blockIdx.x, vh = blk & 1, dir = (blk >> 1) & 1, h = (blk >> 2) & 3, b = blk >> 4, lane = threadIdx.x;
    __shared__ __attribute__((aligned(16))) float sf[8][128];
    __shared__ __attribute__((aligned(16))) float sk[8][128];
    __shared__ __attribute__((aligned(16))) float sq[8][128];
    __shared__ float si[8][64];
    float S[128];
#pragma unroll
    for (int d = 0; d < 128; ++d) S[d] = 0.f;
    bf16_t* OUT = dir == 0 ? ORF : ORB;
    const int cg = (dir == 0 ? C_FF : C_FB) + h * 128, cq = C_QR + h * 128, ci = C_IR + h * 128 + vh * 64;
    for (int n0 = 0; n0 < TPB; n0 += 8) {
        for (int idx = lane; idx < 8 * 128; idx += 64) {
            const int tt = idx >> 7, d = idx & 127;
            const size_t row = (size_t)b * TPB + hg_pos(dir, n0 + tt);
            const float g = bf2f(P[row * PW + cg + d]);
            const float f = __expf(g);
            sf[tt][d] = f; sk[tt][d] = 1.f - f; sq[tt][d] = bf2f(P[row * PW + cq + d]);
        }
        for (int idx = lane; idx < 8 * 64; idx += 64) {
            const int tt = idx >> 6, l = idx & 63;
            const size_t row = (size_t)b * TPB + hg_pos(dir, n0 + tt);
            si[tt][l] = bf2f(P[row * PW + ci + l]);
        }
        __syncthreads();
        for (int tt = 0; tt < 8; ++tt) {
            const float iv = si[tt][lane];
            float o = 0.f;
#pragma unroll
            for (int d4 = 0; d4 < 32; ++d4) {
                const float4 f4 = *(const float4*)&sf[tt][d4 * 4];
                const float4 k4 = *(const float4*)&sk[tt][d4 * 4];
                const float4 q4 = *(const float4*)&sq[tt][d4 * 4];
                S[d4 * 4 + 0] = f4.x * S[d4 * 4 + 0] + k4.x * iv; o += S[d4 * 4 + 0] * q4.x;
                S[d4 * 4 + 1] = f4.y * S[d4 * 4 + 1] + k4.y * iv; o += S[d4 * 4 + 1] * q4.y;
                S[d4 * 4 + 2] = f4.z * S[d4 * 4 + 2] + k4.z * iv; o += S[d4 * 4 + 2] * q4.z;
                S[d4 * 4 + 3] = f4.w * S[d4 * 4 + 3] + k4.w * iv; o += S[d4 * 4 + 3] * q4.w;
            }
            const int pos = hg_pos(dir, n0 + tt);
            if (pos >= CTX) OUT[(size_t)(b * SEQ + pos - CTX) * 512 + h * 128 + vh * 64 + lane] = f2bf(o);
        }
        __syncthreads();
    }
}

__global__ void __launch_bounds__(256) k_mixprep(const bf16_t* __restrict__ P, const bf16_t* __restrict__ OA, const bf16_t* __restrict__ ORF, const bf16_t* __restrict__ ORB,
                                                 const float* __restrict__ ag, const float* __restrict__ hg, bf16_t* MIXIN) {
    const int tok = blockIdx.x, tid = threadIdx.x, b = tok / SEQ, t = tok % SEQ;
    const size_t row = (size_t)b * TPB + CTX + t;
    {
        const unsigned u = *(const unsigned*)(OA + (size_t)tok * 512 + 2 * tid);
        const float x1 = __uint_as_float(u << 16), x2 = __uint_as_float(u & 0xffff0000u);
        const float rstd = rsqrtf(half_sum(x1 * x1 + x2 * x2) * (1.f / 64.f) + EPS);
        *(unsigned*)(MIXIN + (size_t)tok * 1024 + 2 * tid) = f2bf(x1 * rstd * ag[2 * tid]) | ((unsigned)f2bf(x2 * rstd * ag[2 * tid + 1]) << 16);
    }
    {
        const unsigned u = *(const unsigned*)(ORF + (size_t)tok * 512 + 2 * tid), w = *(const unsigned*)(ORB + (size_t)tok * 512 + 2 * tid);
        const unsigned g = *(const unsigned*)(P + row * PW + C_GR + 2 * tid);
        const float x1 = __uint_as_float(u << 16) + __uint_as_float(w << 16), x2 = __uint_as_float(u & 0xffff0000u) + __uint_as_float(w & 0xffff0000u);
        const float rstd = rsqrtf(wave_sum(x1 * x1 + x2 * x2) * (1.f / 128.f) + EPS);
        const float g1 = __uint_as_float(g << 16), g2 = __uint_as_float(g & 0xffff0000u);
        *(unsigned*)(MIXIN + (size_t)tok * 1024 + 512 + 2 * tid) = f2bf(x1 * rstd * hg[2 * tid] * g1) | ((unsigned)f2bf(x2 * rstd * hg[2 * tid + 1] * g2) << 16);
    }
}

__global__ void __launch_bounds__(256) k_res_route(const float* __restrict__ x, const float* __restrict__ MIX, const float* __restrict__ mod, const float* __restrict__ g2,
                                                   const float* __restrict__ wrg, const float* __restrict__ brg, const float* __restrict__ wre, const float* __restrict__ bre,
                                                   float* X1, bf16_t* H2, int* ctl, int* list, float* ew) {
    __shared__ float red[4];
    __shared__ float part[4][36];
    const int tok = blockIdx.x, tid = threadIdx.x, b = tok / SEQ, k = tid * 4;
    const float* m = mod + b * 6144;
    const float4 xv = *(const float4*)(x + (size_t)tok * D + k);
    const float4 mv = *(const float4*)(MIX + (size_t)tok * D + k);
    float x1[4] = {xv.x + m[2048 + k] * mv.x, xv.y + m[2048 + k + 1] * mv.y, xv.z + m[2048 + k + 2] * mv.z, xv.w + m[2048 + k + 3] * mv.w};
    *(float4*)(X1 + (size_t)tok * D + k) = make_float4(x1[0], x1[1], x1[2], x1[3]);
    float ss = wave_sum(x1[0] * x1[0] + x1[1] * x1[1] + x1[2] * x1[2] + x1[3] * x1[3]);
    if ((tid & 63) == 0) red[tid >> 6] = ss;
    __syncthreads();
    const float rstd = rsqrtf((red[0] + red[1] + red[2] + red[3]) * (1.f / D) + EPS);
    float h2[4]; bf16_t o[4];
#pragma unroll
    for (int i = 0; i < 4; ++i) { h2[i] = x1[i] * rstd * g2[k + i] * (1.f + m[4096 + k + i]) + m[3072 + k + i]; o[i] = f2bf(h2[i]); }
    uint2 pk; pk.x = o[0] | ((unsigned)o[1] << 16); pk.y = o[2] | ((unsigned)o[3] << 16);
    *(uint2*)(H2 + (size_t)tok * D + k) = pk;
    float pr[36];
#pragma unroll
    for (int j = 0; j < 36; ++j) pr[j] = 0.f;
#pragma unroll
    for (int i = 0; i < 4; ++i) {
        const float4 wg = *(const float4*)(wrg + (size_t)(k + i) * 4);
        pr[0] += h2[i] * wg.x; pr[1] += h2[i] * wg.y; pr[2] += h2[i] * wg.z; pr[3] += h2[i] * wg.w;
#pragma unroll
        for (int j4 = 0; j4 < 8; ++j4) {
            const float4 we = *(const float4*)(wre + (size_t)(k + i) * 32 + j4 * 4);
            pr[4 + j4 * 4 + 0] += h2[i] * we.x; pr[4 + j4 * 4 + 1] += h2[i] * we.y; pr[4 + j4 * 4 + 2] += h2[i] * we.z; pr[4 + j4 * 4 + 3] += h2[i] * we.w;
        }
    }
#pragma unroll
    for (int j = 0; j < 36; ++j) { const float v = wave_sum(pr[j]); if ((tid & 63) == 0) part[tid >> 6][j] = v; }
    __syncthreads();
    if (tid == 0) {
        float lg[4]; int gs = 0; float gm = -1e30f;
        for (int g = 0; g < 4; ++g) { lg[g] = part[0][g] + part[1][g] + part[2][g] + part[3][g] + brg[g]; if (lg[g] > gm) { gm = lg[g]; gs = g; } }
        float z = 0.f; for (int g = 0; g < 4; ++g) z += expf(lg[g] - gm);
        const float pg = 1.f / z;
        float le[8];
        for (int j = 0; j < 8; ++j) le[j] = part[0][4 + gs * 8 + j] + part[1][4 + gs * 8 + j] + part[2][4 + gs * 8 + j] + part[3][4 + gs * 8 + j] + bre[gs * 8 + j];
        int e1 = 0; float m1 = -1e30f; for (int j = 0; j < 8; ++j) if (le[j] > m1) { m1 = le[j]; e1 = j; }
        int e2 = 0; float m2 = -1e30f; for (int j = 0; j < 8; ++j) if (j != e1 && le[j] > m2) { m2 = le[j]; e2 = j; }
        const float r = expf(m2 - m1);
        const float w1 = pg / (1.f + r), w2 = pg * r / (1.f + r);
        const int E1 = gs * 8 + e1, E2 = gs * 8 + e2;
        ew[tok * 2] = w1; ew[tok * 2 + 1] = w2;
        const int p1 = atomicAdd(&ctl[CT_CNT + E1], 1); list[E1 * LISTCAP + p1] = tok * 2;
        const int p2 = atomicAdd(&ctl[CT_CNT + E2], 1); list[E2 * LISTCAP + p2] = tok * 2 + 1;
    }
}

__global__ void k_moe_tiles(int* ctl) {
    if (threadIdx.x == 0 && blockIdx.x == 0) {
        int nt = 0, slot = 0;
        for (int e = 0; e < NEXP; ++e) {
            const int c = ctl[CT_CNT + e], n = (c + 63) / 64;
            for (int i = 0; i < n; ++i) { ctl[CT_TE + nt] = e; ctl[CT_TI + nt] = i * 64; ctl[CT_TS + nt] = slot + i * 64; ++nt; }
            slot += n * 64;
        }
        ctl[CT_NT] = nt;
    }
}

__global__ void __launch_bounds__(256) k_combine(float* out, const bf16_t* __restrict__ YS, const float* __restrict__ mod) {
    const int tok = blockIdx.x, tid = threadIdx.x, b = tok / SEQ, k = tid * 4;
    const float* m = mod + b * 6144 + 5120;
    float4 v = *(float4*)(out + (size_t)tok * D + k);
    const uint2 a = *(const uint2*)(YS + (size_t)(tok * 2) * D + k), c = *(const uint2*)(YS + (size_t)(tok * 2 + 1) * D + k);
    v.x += m[k] * (__uint_as_float(a.x << 16) + __uint_as_float(c.x << 16));
    v.y += m[k + 1] * (__uint_as_float(a.x & 0xffff0000u) + __uint_as_float(c.x & 0xffff0000u));
    v.z += m[k + 2] * (__uint_as_float(a.y << 16) + __uint_as_float(c.y << 16));
    v.w += m[k + 3] * (__uint_as_float(a.y & 0xffff0000u) + __uint_as_float(c.y & 0xffff0000u));
    *(float4*)(out + (size_t)tok * D + k) = v;
}

extern "C" void kernel_launch(void* const* d_in, const int* in_sizes, int n_in, void* d_out, int out_size, void* d_ws, size_t ws_size, hipStream_t stream) {
    const float* x = (const float*)d_in[0]; const float* c = (const float*)d_in[1]; const float* ctx = (const float*)d_in[2]; const float* c_ctx = (const float*)d_in[3];
    const float* w_ada = (const float*)d_in[4]; const float* b_ada = (const float*)d_in[5]; const float* norm1_g = (const float*)d_in[6]; const float* norm2_g = (const float*)d_in[7];
    const float* w_in = (const float*)d_in[8]; const float* q_norm_g = (const float*)d_in[9]; const float* k_norm_g = (const float*)d_in[10]; const float* attn_out_g = (const float*)d_in[11];
    const float* hgrn_lb = (const float*)d_in[12]; const float* hgrn_out_g = (const float*)d_in[13]; const float* w_out = (const float*)d_in[14];
    const float* wrg = (const float*)d_in[15]; const float* brg = (const float*)d_in[16]; const float* wre = (const float*)d_in[17]; const float* bre = (const float*)d_in[18];
    const float* weg = (const float*)d_in[19]; const float* weu = (const float*)d_in[20]; const float* wed = (const float*)d_in[21];
    float* out = (float*)d_out;
    char* ws = (char*)d_ws;
    if (ws_size < 460 * MiB) { fprintf(stderr, "kernel_launch: workspace too small: %zu\n", ws_size); return; }
    int* ctl = (int*)(ws + WS_CTL);
    float* mod = (float*)(ws + WS_MOD); float* lb = (float*)(ws + WS_MOD + 256 * 1024);
    bf16_t* H = (bf16_t*)(ws + WS_H); bf16_t* P = (bf16_t*)(ws + WS_P);
    bf16_t* OA = (bf16_t*)(ws + WS_OA); bf16_t* ORF = (bf16_t*)(ws + WS_ORF); bf16_t* ORB = (bf16_t*)(ws + WS_ORB);
    bf16_t* H2 = (bf16_t*)(ws + WS_H2); float* ew = (float*)(ws + WS_RT); int* list = (int*)(ws + WS_RT + 1 * MiB);
    bf16_t* MIXIN = (bf16_t*)(ws + WS_H); float* MIX = (float*)(ws + WS_MIX); bf16_t* ACT = (bf16_t*)(ws + WS_ACT); bf16_t* YS = (bf16_t*)(ws + WS_YS);

    hipMemsetAsync(ctl, 0, 64 * 1024, stream);
    k_adaln<<<24, 256, 0, stream>>>(c, c_ctx, w_ada, b_ada, hgrn_lb, mod, lb);
    k_modulate1<<<NROW, 256, 0, stream>>>(x, ctx, norm1_g, mod, H);
    { GemmArgs a{}; a.A = H; a.W = w_in; a.out = P; a.K = 1024; a.ldw = PW; k_gemm<0><<<dim3(PW / 64, NROW / 64), 256, 0, stream>>>(a); }
    k_post<<<NROW, 256, 0, stream>>>(P, q_norm_g, k_norm_g, lb);
    k_attn_naive<<<NB * 8 * 16, 256, 0, stream>>>(P, OA);
    k_hgrn_naive<<<NB * 4 * 2 * 2, 64, 0, stream>>>(P, ORF, ORB);
    k_mixprep<<<NLAT, 256, 0, stream>>>(P, OA, ORF, ORB, attn_out_g, hgrn_out_g, MIXIN);
    { GemmArgs a{}; a.A = MIXIN; a.W = w_out; a.out = MIX; a.K = 1024; a.ldw = 1024; k_gemm<1><<<dim3(1024 / 64, NLAT / 64), 256, 0, stream>>>(a); }
    k_res_route<<<NLAT, 256, 0, stream>>>(x, MIX, mod, norm2_g, wrg, brg, wre, bre, out, H2, ctl, list, ew);
    k_moe_tiles<<<1, 64, 0, stream>>>(ctl);
    { GemmArgs a{}; a.A = H2; a.W = weg; a.W2 = weu; a.out = ACT; a.ctl = ctl; a.list = list; a.ew = ew; a.K = 1024; a.ldw = 512; k_gemm<2><<<dim3(512 / 64, MAXTILES), 256, 0, stream>>>(a); }
    { GemmArgs a{}; a.A = ACT; a.W = wed; a.out = YS; a.ctl = ctl; a.list = list; a.ew = ew; a.K = 512; a.ldw = 1024; k_gemm<3><<<dim3(1024 / 64, MAXTILES), 256, 0, stream>>>(a); }
    k_combine<<<NLAT, 256, 0, stream>>>(out, YS, mod);
}
```

```cpp
#include <hip/hip_runtime.h>
#include <hip/hip_cooperative_groups.h>
#include <cstdio>
#include <cstdint>
namespace cg = cooperative_groups;

typedef unsigned short bf16_t;
__device__ __forceinline__ float bf2f(bf16_t v) { return __uint_as_float(((unsigned)v) << 16); }
__device__ __forceinline__ bf16_t f2bf(float f) { unsigned u = __float_as_uint(f); return (bf16_t)((u + 0x7fffu + ((u >> 16) & 1u)) >> 16); }
__device__ __forceinline__ unsigned pk2(float lo, float hi) { return (unsigned)f2bf(lo) | ((unsigned)f2bf(hi) << 16); }

constexpr int D = 1024, NB = 8, SEQ = 4096, CTX = 256, TPB = SEQ + CTX;
constexpr int NROW = NB * TPB;
constexpr int NLAT = NB * SEQ;
constexpr int PW = 3328;
constexpr int NEXP = 32, FFE = 512;
constexpr float EPS = 1e-6f;
constexpr int LISTCAP = NLAT;
constexpr int MAXTILES = 65536 / 64 + 32;
constexpr float C2 = 0.125f * 1.4426950408889634f;

constexpr size_t MiB = 1ull << 20;
constexpr size_t WS_CTL = 0;
constexpr size_t WS_MOD = 1 * MiB;
constexpr size_t WS_WRT = 1 * MiB + 512 * 1024;
constexpr size_t WS_WTIN = 2 * MiB;
constexpr size_t WS_WTOUT = 9 * MiB;
constexpr size_t WS_UT = 11 * MiB;
constexpr size_t WS_DEC = 147 * MiB;
constexpr size_t WS_H = 107 * MiB;
constexpr size_t WS_QA = 175 * MiB;
constexpr size_t WS_KA = 207 * MiB;
constexpr size_t WS_VA = 216 * MiB;
constexpr size_t WS_QR = 225 * MiB;
constexpr size_t WS_GF = 259 * MiB;
constexpr size_t WS_GB = 293 * MiB;
constexpr size_t WS_IV = 327 * MiB;
constexpr size_t WS_GR = 361 * MiB;
constexpr size_t WS_ORF = 393 * MiB, WS_ORB = 425 * MiB;
constexpr size_t WS_RT = 489 * MiB;
constexpr size_t WS_SEL = WS_RT + 256 * 1024;
constexpr size_t WS_SMAP = WS_RT + 512 * 1024;
constexpr size_t WS_END = 494 * MiB;
constexpr size_t WS_MIXIN = 11 * MiB;
constexpr size_t WS_WGU = 11 * MiB;
constexpr size_t WS_WDN = 75 * MiB;
constexpr size_t WS_H2M = 107 * MiB;
constexpr size_t WS_H2S = 175 * MiB;
constexpr size_t WS_ACT2 = 319 * MiB;
constexpr size_t WS_YS2 = 175 * MiB;
constexpr int MAXT256 = 65536 / 256 + 32;
constexpr int NCHUNK = TPB / 64;
constexpr int NHUNIT = NB * 4 * 2 * NCHUNK;

constexpr int CT_CNT = 0, CT_NT = 32, CT_TE = 64, CT_TI = CT_TE + MAXTILES, CT_TS = CT_TI + MAXTILES;

__device__ __forceinline__ float wave_sum(float v) {
#pragma unroll
    for (int o = 32; o >= 1; o >>= 1) v += __shfl_xor(v, o);
    return v;
}
__device__ __forceinline__ float half_sum(float v) {
#pragma unroll
    for (int o = 16; o >= 1; o >>= 1) v += __shfl_xor(v, o);
    return v;
}
namespace pg8 {
#define PG8_LAS __attribute__((address_space(3)))
typedef unsigned short bf16_t;
typedef short bf16x8 __attribute__((ext_vector_type(8)));
typedef float f32x4 __attribute__((ext_vector_type(4)));
typedef unsigned u32x4 __attribute__((ext_vector_type(4)));
constexpr int BM = 256, BK = 64, HALF = 128, HTB = HALF * BK * 2  , STAGE_BYTES = 8 * HTB, NXCD = 8, WGM = 8;

__host__ __device__ __forceinline__ int lds_byte(int r, int c) { const int st = (r >> 4) * 2 + (c >> 5), rr = r & 15, cc = c & 31, ob = rr * 64 + cc * 2; return st * 1024 + (ob ^ (((ob >> 9) & 1) << 5)); }
__host__ __device__ __forceinline__ void stage_rc(int b, int& R, int& C) { const int st = b / 1024, sb = b % 1024, swz = sb ^ (((sb >> 9) & 1) << 5); R = (st >> 1) * 16 + swz / 64; C = (st & 1) * 32 + (swz % 64) / 2; }
__host__ __device__ __forceinline__ int perm32(int rho) { const int n = rho >> 4, i = rho & 15; return 8 * (i >> 2) + 4 * n + (i & 3); }

struct Unit { int pm, pn; };
struct Gemm { const bf16_t* A; const bf16_t* Bt; int M, N, K; };

struct StaticOrder {
    int nM, nN, nwg, G, c;
    __host__ __device__ void init(int M, int N, int G_, int c_) { nM = M / BM; nN = N / BM; nwg = nM * nN; G = G_; c = c_; }
    __host__ __device__ bool next(int i, Unit& u) const {
        const long L = (long)i * G + c; if (L >= nwg) return false;
        int wgid = (int)L; { const int q = nwg / NXCD, r = nwg % NXCD, xcd = wgid % NXCD, off = wgid / NXCD; wgid = (xcd < r ? xcd * (q + 1) : r * (q + 1) + (xcd - r) * q) + off; }
        const int nig = WGM * nN, gid = wgid / nig, fm = gid * WGM, gsz = (nM - fm) < WGM ? (nM - fm) : WGM;
        u.pm = fm + ((wgid % nig) % gsz); u.pn = (wgid % nig) / gsz; return true;
    }
    __device__ __forceinline__ const char* aptr(const Gemm& g, const Unit& u, size_t tstep) const { return (const char*)g.A + (size_t)u.pm * tstep; }
    __device__ __forceinline__ const char* bptr(const Gemm& g, const Unit& u, size_t tstep) const { return (const char*)g.Bt + (size_t)u.pn * tstep; }
    __device__ __forceinline__ void a_ready(const Unit&) const {}
    __device__ __forceinline__ void done(const Unit&) const {}
};
__device__ __forceinline__ unsigned cvt_pk_bf16(float lo, float hi) { unsigned r; asm volatile("v_cvt_pk_bf16_f32 %0, %1, %2" : "=v"(r) : "v"(lo), "v"(hi)); return r; }
typedef float f32x2 __attribute__((ext_vector_type(2)));
__device__ __forceinline__ float fsigmoid(float x) { return __builtin_amdgcn_rcpf(1.f + __expf(-x)); }

struct EpiInproj {
    static constexpr bool PERM = true, AFTER_DRAIN = false;
    bf16_t *QA, *KA, *VA, *QR, *GF, *GB, *IV, *GR; const float *qg, *kg, *lb; const PG8_LAS f32x2* rope;
    __device__ __forceinline__ void operator()(const f32x4 (&acc)[2][2][4][2], const Unit& u, int wr, int wc, int fr, int fq) const {
        const int pn = u.pn, pmb = u.pm / 17, pmr = u.pm % 17;
        const bool isctx = (pmr == 0);
        if (pn <= 2) {
            const bool isV = (pn == 2) && (wc >= 2);
            if (pn < 2 && isctx) return;
            float gv[2][2][4];
            const float* gsrc = pn < 2 ? qg : kg;
#pragma unroll
            for (int bj = 0; bj < 2; ++bj)
#pragma unroll
                for (int n = 0; n < 2; ++n) { const f32x4 t = *(const f32x4*)(gsrc + 32 * bj + 8 * fq + 4 * n); gv[bj][n][0] = t[0]; gv[bj][n][1] = t[1]; gv[bj][n][2] = t[2]; gv[bj][n][3] = t[3]; }
            const float osc = pn < 2 ? C2 : 1.0f;
#pragma unroll
            for (int ai = 0; ai < 2; ++ai)
#pragma unroll
                for (int m = 0; m < 4; ++m) {
                    const int rl = 128 * ai + 64 * wr + 16 * m + fr;
                    const size_t grow = (size_t)u.pm * 256 + rl;
                    f32x4 v[2][2];
#pragma unroll
                    for (int bj = 0; bj < 2; ++bj)
#pragma unroll
                        for (int n = 0; n < 2; ++n) v[bj][n] = acc[ai][bj][m][n];
                    if (!isV) {
                        float ss = 0.f;
#pragma unroll
                        for (int bj = 0; bj < 2; ++bj)
#pragma unroll
                            for (int n = 0; n < 2; ++n) ss += (v[bj][n][0] * v[bj][n][0] + v[bj][n][1] * v[bj][n][1]) + (v[bj][n][2] * v[bj][n][2] + v[bj][n][3] * v[bj][n][3]);
                        ss += __shfl_xor(ss, 16); ss += __shfl_xor(ss, 32);
                        const float rstd = rsqrtf(ss * (1.f / 64.f) + EPS) * osc;
                        const int ri = 4 * (pmr - 1) + 2 * ai + wr, ci = 16 * m + fr;
#pragma unroll
                        for (int bj = 0; bj < 2; ++bj) {
                            const int posv = bj ? ci : ri;
#pragma unroll
                            for (int n = 0; n < 2; ++n)
#pragma unroll
                                for (int p = 0; p < 2; ++p) {
                                    f32x2 cs = (f32x2){1.f, 0.f};
                                    if (!isctx) cs = rope[posv * 16 + 4 * fq + 2 * n + p];
                                    const float x1 = v[bj][n][2 * p] * rstd * gv[bj][n][2 * p], x2 = v[bj][n][2 * p + 1] * rstd * gv[bj][n][2 * p + 1];
                                    v[bj][n][2 * p] = x1 * cs.x - x2 * cs.y; v[bj][n][2 * p + 1] = x1 * cs.y + x2 * cs.x;
                                }
                        }
                    }
                    bf16_t* dst;
                    if (pn < 2) dst = QA + ((size_t)pmb * SEQ + (size_t)(pmr - 1) * 256 + rl) * 512 + (4 * pn + wc) * 64 + 8 * fq;
                    else if (!isV) dst = KA + grow * 128 + wc * 64 + 8 * fq;
                    else dst = VA + grow * 128 + (wc - 2) * 64 + 8 * fq;
#pragma unroll
                    for (int bj = 0; bj < 2; ++bj) {
                        u32x4 w; w.x = cvt_pk_bf16(v[bj][0][0], v[bj][0][1]); w.y = cvt_pk_bf16(v[bj][0][2], v[bj][0][3]); w.z = cvt_pk_bf16(v[bj][1][0], v[bj][1][1]); w.w = cvt_pk_bf16(v[bj][1][2], v[bj][1][3]);
                        *(u32x4*)(dst + 32 * bj) = w;
                    }
                }
            return;
        }
        const int seg = pn <= 4 ? 0 : (pn <= 8 ? 1 : (pn <= 10 ? 2 : 3));
        if (seg == 3 && isctx) return;
        int cb; bf16_t* base; int dir = 0;
        if (seg == 0) { cb = 256 * (pn - 3); base = QR; }
        else if (seg == 1) { dir = (pn - 5) >> 1; cb = 256 * ((pn - 5) & 1); base = dir ? GB : GF; }
        else if (seg == 2) { cb = 256 * (pn - 9); base = IV; }
        else { cb = 256 * (pn - 11); base = GR; }
        const int c0 = cb + 32 * wc + 8 * fq;
        f32x4 lbv[2][2];
        if (seg == 1) {
#pragma unroll
            for (int bj = 0; bj < 2; ++bj)
#pragma unroll
                for (int n = 0; n < 2; ++n) lbv[bj][n] = *(const f32x4*)(lb + dir * 512 + c0 + 128 * bj + 4 * n);
        }
#pragma unroll
        for (int ai = 0; ai < 2; ++ai)
#pragma unroll
            for (int m = 0; m < 4; ++m) {
                const int rl = 128 * ai + 64 * wr + 16 * m + fr;
                const size_t drow = seg == 3 ? ((size_t)pmb * SEQ + (size_t)(pmr - 1) * 256 + rl) : ((size_t)u.pm * 256 + rl);
                bf16_t* dst = base + drow * 512 + c0;
#pragma unroll
                for (int bj = 0; bj < 2; ++bj) {
                    f32x4 v0 = acc[ai][bj][m][0], v1 = acc[ai][bj][m][1];
                    if (seg == 0) {
#pragma unroll
                        for (int i = 0; i < 4; ++i) { v0[i] = v0[i] * fsigmoid(v0[i]) * 0.08838834764831845f; v1[i] = v1[i] * fsigmoid(v1[i]) * 0.08838834764831845f; }
                    } else if (seg == 1) {
#pragma unroll
                        for (int i = 0; i < 4; ++i) { const float l0 = lbv[bj][0][i], l1 = lbv[bj][1][i]; v0[i] = __logf(l0 + (1.f - l0) * fsigmoid(v0[i])); v1[i] = __logf(l1 + (1.f - l1) * fsigmoid(v1[i])); }
                    } else if (seg == 3) {
#pragma unroll
                        for (int i = 0; i < 4; ++i) { v0[i] = v0[i] * fsigmoid(v0[i]); v1[i] = v1[i] * fsigmoid(v1[i]); }
                    }
                    u32x4 w; w.x = cvt_pk_bf16(v0[0], v0[1]); w.y = cvt_pk_bf16(v0[2], v0[3]); w.z = cvt_pk_bf16(v1[0], v1[1]); w.w = cvt_pk_bf16(v1[2], v1[3]);
                    *(u32x4*)(dst + 128 * bj) = w;
                }
            }
    }
};

struct EpiOutproj {
    static constexpr bool PERM = false, AFTER_DRAIN = false;
    const float* x; const float* mod; float* X1;
    __device__ __forceinline__ void operator()(const f32x4 (&acc)[2][2][4][2], const Unit& u, int wr, int wc, int fr, int fq) const {
        const float* gt = mod + (u.pm >> 4) * 6144 + 2048;
        const int row0 = u.pm * BM + wr * 64 + fr, col0 = u.pn * BM + wc * 32 + 4 * fq;
        f32x4 gv[2][2];
#pragma unroll
        for (int bj = 0; bj < 2; ++bj)
#pragma unroll
            for (int n = 0; n < 2; ++n) gv[bj][n] = *(const f32x4*)(gt + col0 + bj * HALF + n * 16);
#pragma unroll
        for (int ai = 0; ai < 2; ++ai)
#pragma unroll
            for (int m = 0; m < 4; ++m) { const size_t off = (size_t)(row0 + ai * HALF + m * 16) * 1024 + col0;
#pragma unroll
                for (int bj = 0; bj < 2; ++bj)
#pragma unroll
                    for (int n = 0; n < 2; ++n) { const f32x4 xv = *(const f32x4*)(x + off + bj * HALF + n * 16); *(f32x4*)(X1 + off + bj * HALF + n * 16) = xv + gv[bj][n] * acc[ai][bj][m][n]; } }
    }
};

struct GroupSched {
    const PG8_LAS int* tile_e; int nunits, G, c; size_t estride;
    __device__ __forceinline__ bool next(int i, Unit& u) const { const int L = i * G + c; if (L >= nunits) return false; u.pm = L >> 2; u.pn = L & 3; return true; }
    __device__ __forceinline__ const char* aptr(const Gemm& g, const Unit& u, size_t tstep) const { return (const char*)g.A + (size_t)u.pm * tstep; }
    __device__ __forceinline__ const char* bptr(const Gemm& g, const Unit& u, size_t tstep) const { return (const char*)g.Bt + (size_t)tile_e[u.pm] * estride + (size_t)u.pn * tstep; }
    __device__ __forceinline__ void a_ready(const Unit&) const {}
    __device__ __forceinline__ void done(const Unit&) const {}
};
struct EpiMoe1 {
    static constexpr bool PERM = true, AFTER_DRAIN = false;
    bf16_t* ACT;
    __device__ __forceinline__ void operator()(const f32x4 (&acc)[2][2][4][2], const Unit& u, int wr, int wc, int fr, int fq) const {
        const int f0 = 128 * u.pn + 32 * wc + 8 * fq;
#pragma unroll
        for (int ai = 0; ai < 2; ++ai)
#pragma unroll
            for (int m = 0; m < 4; ++m) {
                const size_t slot = (size_t)u.pm * 256 + 128 * ai + 64 * wr + 16 * m + fr;
                f32x4 v0, v1;
#pragma unroll
                for (int i = 0; i < 4; ++i) { const float g0 = acc[ai][0][m][0][i], g1 = acc[ai][0][m][1][i]; v0[i] = g0 * fsigmoid(g0) * acc[ai][1][m][0][i]; v1[i] = g1 * fsigmoid(g1) * acc[ai][1][m][1][i]; }
                u32x4 w; w.x = cvt_pk_bf16(v0[0], v0[1]); w.y = cvt_pk_bf16(v0[2], v0[3]); w.z = cvt_pk_bf16(v1[0], v1[1]); w.w = cvt_pk_bf16(v1[2], v1[3]);
                *(u32x4*)(ACT + slot * 512 + f0) = w;
            }
    }
};
struct EpiMoe2 {
    static constexpr bool PERM = true, AFTER_DRAIN = false;
    bf16_t* YS; const int* slotmap; const float* ew; const PG8_LAS int* tile_e; const PG8_LAS int* segt; const PG8_LAS int* cnt;
    __device__ __forceinline__ void operator()(const f32x4 (&acc)[2][2][4][2], const Unit& u, int wr, int wc, int fr, int fq) const {
        const int e = tile_e[u.pm], lim = cnt[e] - (u.pm - segt[e]) * 256;
        const int c0 = 256 * u.pn + 32 * wc + 8 * fq;
#pragma unroll
        for (int ai = 0; ai < 2; ++ai)
#pragma unroll
            for (int m = 0; m < 4; ++m) {
                const int rl = 128 * ai + 64 * wr + 16 * m + fr;
                if (rl < lim) {
                    const int idx = slotmap[u.pm * 256 + rl]; const float w = ew[idx];
                    bf16_t* dst = YS + (size_t)idx * 1024 + c0;
#pragma unroll
                    for (int bj = 0; bj < 2; ++bj) {
                        const f32x4 v0 = acc[ai][bj][m][0] * w, v1 = acc[ai][bj][m][1] * w;
                        u32x4 o; o.x = cvt_pk_bf16(v0[0], v0[1]); o.y = cvt_pk_bf16(v0[2], v0[3]); o.z = cvt_pk_bf16(v1[0], v1[1]); o.w = cvt_pk_bf16(v1[2], v1[3]);
                        *(u32x4*)(dst + 128 * bj) = o;
                    }
                }
            }
    }
};
template <class Epi, class Sched, bool ALIGN_EPI = false, bool SP2 = false>
__device__ __forceinline__ void gemm_phase(PG8_LAS unsigned char* lds, const Gemm g, const Sched& S, const Epi& E) {
    const int tid = threadIdx.x, wid = __builtin_amdgcn_readfirstlane(tid >> 6), lane = tid & 63, wr = wid >> 2, wc = wid & 3, fr = lane & 15, fq = lane >> 4;
    const int K = g.K, nt = K / BK;
    unsigned voffA[2], voffB[2];
#pragma unroll
    for (int i = 0; i < 2; ++i) { int R, C; stage_rc(tid * 16 + i * 8192, R, C); const int Rb = Epi::PERM ? ((R & ~31) + perm32(R & 31)) : R;
        voffA[i] = (unsigned)(R * K + C) * 2u; voffB[i] = (unsigned)(Rb * K + C) * 2u; }
    const size_t kstep = (size_t)(BK * 2);
    const size_t hstep = (size_t)HALF * K * 2;
    const size_t tstep = 2 * hstep;
    const unsigned ldsw = (unsigned)wid * 1024u;
    const int aoff = lds_byte(wr * 64 + fr, fq * 8), boff = lds_byte(wc * 32 + fr, fq * 8);
#define PG8_SA(b, h) (((b) * 2 + (h)) * HTB)
#define PG8_SB(b, h) ((4 + (b) * 2 + (h)) * HTB)
#define PG8_STAGE(bufoff, gbase, voff) do { _Pragma("unroll") for (int _i = 0; _i < 2; ++_i) \
        __builtin_amdgcn_global_load_lds((const unsigned*)((const char*)(gbase) + (voff)[_i]), (PG8_LAS unsigned*)(lds + (bufoff) + ldsw + _i * 8192), 16, 0, 0); } while (0)
#define PG8_LDA(dst, b, h) do { _Pragma("unroll") for (int m = 0; m < 4; ++m) _Pragma("unroll") for (int k = 0; k < 2; ++k) dst[m][k] = *(const PG8_LAS bf16x8*)(lds + PG8_SA(b, h) + aoff + m * 2048 + k * 1024); } while (0)
#define PG8_LDB(dst, b, h) do { _Pragma("unroll") for (int n = 0; n < 2; ++n) _Pragma("unroll") for (int k = 0; k < 2; ++k) dst[n][k] = *(const PG8_LAS bf16x8*)(lds + PG8_SB(b, h) + boff + n * 2048 + k * 1024); } while (0)
#define PG8_MMA(ai, bj, At, Bt) do { __builtin_amdgcn_s_setprio(1); _Pragma("unroll") for (int m = 0; m < 4; ++m) _Pragma("unroll") for (int n = 0; n < 2; ++n) _Pragma("unroll") for (int k = 0; k < 2; ++k) \
        acc[ai][bj][m][n] = __builtin_amdgcn_mfma_f32_16x16x32_bf16(Bt[n][k], At[m][k], acc[ai][bj][m][n], 0, 0, 0); __builtin_amdgcn_s_setprio(0); } while (0)
#define PG8_WAIT_V(n) asm volatile("s_waitcnt vmcnt(" #n ")" ::: "memory")
#define PG8_WAIT_L(n) asm volatile("s_waitcnt lgkmcnt(" #n ")" ::: "memory")
#define PG8_BAR __builtin_amdgcn_s_barrier()
#define PG8_SCHED __builtin_amdgcn_sched_barrier(0)
    Unit cur, nxt; int ui = 0;
    if (!S.next(0, cur)) return;
    f32x4 acc[2][2][4][2];
#pragma unroll
    for (int a = 0; a < 2; ++a)
#pragma unroll
        for (int b = 0; b < 2; ++b)
#pragma unroll
            for (int m = 0; m < 4; ++m)
#pragma unroll
                for (int n = 0; n < 2; ++n) acc[a][b][m][n] = (f32x4){0.f, 0.f, 0.f, 0.f};
    bf16x8 At[4][2], B0[2][2], B1[2][2];
    const char* cA = S.aptr(g, cur, tstep); const char* cB = S.bptr(g, cur, tstep);
    S.a_ready(cur);
    if constexpr (SP2) {
        PG8_STAGE(PG8_SB(0, 0), cB, voffB); PG8_STAGE(PG8_SB(0, 1), cB + hstep, voffB); PG8_STAGE(PG8_SA(0, 0), cA, voffA); PG8_STAGE(PG8_SA(0, 1), cA + hstep, voffA);
        if (wr == 1) PG8_BAR;
        PG8_WAIT_V(2); PG8_BAR;
        PG8_STAGE(PG8_SB(1, 0), cB + kstep, voffB); PG8_STAGE(PG8_SA(1, 0), cA + kstep, voffA); PG8_STAGE(PG8_SB(1, 1), cB + hstep + kstep, voffB);
        PG8_WAIT_V(6); PG8_BAR;
    } else {
        PG8_STAGE(PG8_SB(0, 0), cB, voffB); PG8_STAGE(PG8_SA(0, 0), cA, voffA); PG8_STAGE(PG8_SB(0, 1), cB + hstep, voffB); PG8_STAGE(PG8_SA(0, 1), cA + hstep, voffA);
        if (wr == 1) PG8_BAR;
        PG8_WAIT_V(4); PG8_BAR;
        PG8_STAGE(PG8_SB(1, 0), cB + kstep, voffB); PG8_STAGE(PG8_SA(1, 0), cA + kstep, voffA); PG8_STAGE(PG8_SB(1, 1), cB + hstep + kstep, voffB);
        PG8_WAIT_V(6); PG8_BAR;
    }
    for (;;) {
        const bool has_next = S.next(ui + 1, nxt);
        const char* nA = has_next ? S.aptr(g, nxt, tstep) : cA; const char* nB = has_next ? S.bptr(g, nxt, tstep) : cB;
        for (int t = 0; t < nt; t += 2) {
            const bool last = (t == nt - 2);
            const char* a1 = cA + (size_t)(t + 1) * kstep;
            const char* a2 = last ? nA : cA + (size_t)(t + 2) * kstep; const char* b2 = last ? nB : cB + (size_t)(t + 2) * kstep;
            const char* a3 = a2 + kstep; const char* b3 = b2 + kstep;
            if (last && has_next) S.a_ready(nxt);
            if constexpr (SP2) {
            PG8_LDB(B0, 0, 0); PG8_LDB(B1, 0, 1); PG8_SCHED; PG8_LDA(At, 0, 0); PG8_STAGE(PG8_SA(1, 1), a1 + hstep, voffA);
            PG8_WAIT_V(8); PG8_WAIT_L(0); PG8_BAR; PG8_MMA(0, 0, At, B0); PG8_MMA(0, 1, At, B1); PG8_BAR; PG8_SCHED;
            PG8_LDA(At, 0, 1); PG8_STAGE(PG8_SB(0, 0), b2, voffB); PG8_STAGE(PG8_SB(0, 1), b2 + hstep, voffB); PG8_STAGE(PG8_SA(0, 0), a2, voffA);
            PG8_WAIT_V(8); PG8_WAIT_L(0); PG8_BAR; PG8_MMA(1, 0, At, B0); PG8_MMA(1, 1, At, B1); PG8_BAR; PG8_SCHED;
            PG8_LDB(B0, 1, 0); PG8_LDB(B1, 1, 1); PG8_SCHED; PG8_LDA(At, 1, 0); PG8_STAGE(PG8_SA(0, 1), a2 + hstep, voffA);
            PG8_WAIT_V(8); PG8_WAIT_L(0); PG8_BAR; PG8_MMA(0, 0, At, B0); PG8_MMA(0, 1, At, B1); PG8_BAR; PG8_SCHED;
            PG8_LDA(At, 1, 1); PG8_STAGE(PG8_SB(1, 0), b3, voffB); PG8_STAGE(PG8_SB(1, 1), b3 + hstep, voffB); PG8_STAGE(PG8_SA(1, 0), a3, voffA);
            PG8_WAIT_V(8); PG8_WAIT_L(0); PG8_BAR; PG8_MMA(1, 0, At, B0); PG8_MMA(1, 1, At, B1); PG8_BAR; PG8_SCHED;
            } else {
            PG8_LDB(B0, 0, 0); PG8_SCHED; PG8_LDA(At, 0, 0); PG8_STAGE(PG8_SA(1, 1), a1 + hstep, voffA);
            PG8_WAIT_L(8); PG8_BAR; PG8_WAIT_L(0); PG8_MMA(0, 0, At, B0); PG8_BAR; PG8_SCHED;
            PG8_LDB(B1, 0, 1); PG8_STAGE(PG8_SB(0, 0), b2, voffB);
            PG8_BAR; PG8_WAIT_L(0); PG8_MMA(0, 1, At, B1); PG8_BAR;
            PG8_LDA(At, 0, 1); PG8_STAGE(PG8_SA(0, 0), a2, voffA);
            PG8_BAR; PG8_WAIT_L(0); PG8_MMA(1, 0, At, B0); PG8_BAR; PG8_SCHED;
            PG8_STAGE(PG8_SB(0, 1), b2 + hstep, voffB);
            PG8_WAIT_V(6); PG8_BAR; PG8_MMA(1, 1, At, B1); PG8_BAR;
            PG8_LDB(B0, 1, 0); PG8_SCHED; PG8_LDA(At, 1, 0); PG8_STAGE(PG8_SA(0, 1), a2 + hstep, voffA);
            PG8_WAIT_L(8); PG8_BAR; PG8_WAIT_L(0); PG8_MMA(0, 0, At, B0); PG8_BAR; PG8_SCHED;
            PG8_LDB(B1, 1, 1); PG8_STAGE(PG8_SB(1, 0), b3, voffB);
            PG8_BAR; PG8_WAIT_L(0); PG8_MMA(0, 1, At, B1); PG8_BAR;
            PG8_LDA(At, 1, 1); PG8_STAGE(PG8_SA(1, 0), a3, voffA);
            PG8_BAR; PG8_WAIT_L(0); PG8_MMA(1, 0, At, B0); PG8_BAR; PG8_SCHED;
            PG8_STAGE(PG8_SB(1, 1), b3 + hstep, voffB);
            PG8_WAIT_V(6); PG8_BAR; PG8_MMA(1, 1, At, B1); PG8_BAR;
            }
        }
        if constexpr (ALIGN_EPI) { if (wr == 0) PG8_BAR; }
        if constexpr (!Epi::AFTER_DRAIN) { E(acc, cur, wr, wc, fr, fq); S.done(cur); }
        if (!has_next) break;
#pragma unroll
        for (int a = 0; a < 2; ++a)
#pragma unroll
            for (int b = 0; b < 2; ++b)
#pragma unroll
                for (int m = 0; m < 4; ++m)
#pragma unroll
                    for (int n = 0; n < 2; ++n) acc[a][b][m][n] = (f32x4){0.f, 0.f, 0.f, 0.f};
        cur = nxt; cA = nA; cB = nB; ++ui;
        if constexpr (ALIGN_EPI) { if (wr == 1) PG8_BAR; }
    }
    PG8_WAIT_V(0);
    if constexpr (!ALIGN_EPI) { if (wr == 0) PG8_BAR; }
    PG8_BAR;
    if constexpr (Epi::AFTER_DRAIN) { E.fused(acc, cur, wr, wc, fr, fq, lds, wid, lane); S.done(cur); }
#undef PG8_SA
#undef PG8_SB
#undef PG8_STAGE
#undef PG8_LDA
#undef PG8_LDB
#undef PG8_MMA
#undef PG8_WAIT_V
#undef PG8_WAIT_L
#undef PG8_BAR
#undef PG8_SCHED
}
}
#include <hip/hip_bf16.h>
#include <cmath>
namespace attn_body {
using bf16=__hip_bfloat16;
using bf16x8=__attribute__((ext_vector_type(8)))short;
using s16x4=__attribute__((ext_vector_type(4)))short;
using f32x16=__attribute__((ext_vector_type(16)))float;
using u32x4=__attribute__((ext_vector_type(4)))unsigned;
constexpr int D=64,QP=512,KVP=128,OP=512,SEQQ=4096,SEQK=4352;
constexpr int NW=8,QBLK=32,QB=QBLK*NW,KVBLK=64,NQB=SEQQ/QB;
constexpr int ATTN_UNIT_ROWS=QB;
__device__ __forceinline__ int crow(int r,int hi){return (r&3)+8*(r>>2)+4*hi;}
#define SBAR() __builtin_amdgcn_sched_barrier(0)
__device__ __forceinline__ void cmask(f32x16&p0,f32x16&p1,int jb,int qrel,int hi){
  const float NEG=-INFINITY; int kb=64*jb+4*hi;
  #pragma unroll
  for(int r=0;r<16;++r){int kv=kb+(r&3)+8*(r>>2); if(kv>qrel)p0[r]=NEG; if(kv+32>qrel)p1[r]=NEG;}
}

constexpr int NSLOT=3, SLOTB=8192;
constexpr int LDS_K=0, LDS_V=NSLOT*SLOTB, LDS_WS=2*NSLOT*SLOTB, LDS_OST=LDS_WS+NW*64*4, LDS_BYTES=LDS_OST+NW*4096;
constexpr float C2=0.125f*1.4426950408889634f;
__device__ __forceinline__ void glds16(const void*gsrc,unsigned lds_dst){unsigned keep;
  asm volatile("s_mov_b32 %0, m0\n\ts_mov_b32 m0, %2\n\ts_nop 0\n\tglobal_load_lds_dwordx4 %1, off\n\ts_mov_b32 m0, %0":"=&s"(keep):"v"(gsrc),"s"(lds_dst):"memory");}
__device__ __forceinline__ float max3f(float a,float b,float c){float r;asm("v_max3_f32 %0, %1, %2, %3":"=v"(r):"v"(a),"v"(b),"v"(c));return r;}
__device__ __forceinline__ float max2f(float a,float b){float r;asm("v_max_f32_e32 %0, %1, %2":"=v"(r):"v"(a),"v"(b));return r;}
__device__ __forceinline__ float fadd_s(float a,float b){float r;asm("v_add_f32_e32 %0, %1, %2":"=v"(r):"v"(a),"v"(b));return r;}
__device__ __forceinline__ float fsub_s(float a,float b){float r;asm("v_sub_f32_e32 %0, %1, %2":"=v"(r):"v"(a),"v"(b));return r;}
typedef float f32x2_t __attribute__((ext_vector_type(2))); typedef __bf16 bf16x2_t __attribute__((ext_vector_type(2)));
__device__ __forceinline__ unsigned cvtpk_s(float lo,float hi){f32x2_t v={lo,hi};bf16x2_t b=__builtin_convertvector(v,bf16x2_t);return __builtin_bit_cast(unsigned,b);}
#define WAIT_BAR(N) asm volatile("s_waitcnt vmcnt(" #N ") lgkmcnt(0)\n\ts_barrier":::"memory")

__device__ __forceinline__ void qkt(f32x16&p0,f32x16&p1,const char*Kslot,const bf16x8*qr,const f32x16&negm,int r32,int hi){
  const char*kb=Kslot+hi*1024+r32*16;
  #pragma unroll
  for(int d0=0;d0<4;++d0){
    const bf16x8 b0=*reinterpret_cast<const bf16x8*>(kb+d0*2048);
    const bf16x8 b1=*reinterpret_cast<const bf16x8*>(kb+d0*2048+512);
    if(d0==0){p0=__builtin_amdgcn_mfma_f32_32x32x16_bf16(b0,qr[0],negm,0,0,0);p1=__builtin_amdgcn_mfma_f32_32x32x16_bf16(b1,qr[0],negm,0,0,0);}
    else{p0=__builtin_amdgcn_mfma_f32_32x32x16_bf16(b0,qr[d0],p0,0,0,0);p1=__builtin_amdgcn_mfma_f32_32x32x16_bf16(b1,qr[d0],p1,0,0,0);}}
}
typedef __attribute__((address_space(3))) const char* lds_cptr;
typedef short v4i16_t __attribute__((ext_vector_type(4)));
__device__ __forceinline__ void kload8(bf16x8*kf,lds_cptr kp){
  kf[0]=*(const __attribute__((address_space(3))) bf16x8*)(kp);      kf[1]=*(const __attribute__((address_space(3))) bf16x8*)(kp+512);
  kf[2]=*(const __attribute__((address_space(3))) bf16x8*)(kp+2048); kf[3]=*(const __attribute__((address_space(3))) bf16x8*)(kp+2560);
  kf[4]=*(const __attribute__((address_space(3))) bf16x8*)(kp+4096); kf[5]=*(const __attribute__((address_space(3))) bf16x8*)(kp+4608);
  kf[6]=*(const __attribute__((address_space(3))) bf16x8*)(kp+6144); kf[7]=*(const __attribute__((address_space(3))) bf16x8*)(kp+6656);
}
__device__ __forceinline__ void kload2(bf16x8*kf,lds_cptr kp,int j){ kf[2*j]=*(const __attribute__((address_space(3))) bf16x8*)(kp+j*2048); kf[2*j+1]=*(const __attribute__((address_space(3))) bf16x8*)(kp+j*2048+512); }
__device__ __forceinline__ s16x4 vtr(lds_cptr p){ return __builtin_bit_cast(s16x4,__builtin_amdgcn_ds_read_tr16_b64_v4i16((__attribute__((address_space(3))) v4i16_t*)p)); }
__device__ __forceinline__ float rowmax(const f32x16&p0,const f32x16&p1){
  float a=max3f(p0[0],p0[1],p1[0]),b=max3f(p0[2],p0[3],p1[1]);a=max3f(a,p1[2],p1[3]);
  #pragma unroll
  for(int r=4;r<16;r+=4){a=max3f(a,p0[r],p0[r+1]);b=max3f(b,p0[r+2],p0[r+3]);a=max3f(a,p1[r],p1[r+1]);b=max3f(b,p1[r+2],p1[r+3]);}
  const float m=max2f(a,b);
  auto rr=__builtin_amdgcn_permlane32_swap(__float_as_uint(m),__float_as_uint(m),false,false);
  return max2f(__uint_as_float(rr[0]),__uint_as_float(rr[1]));
}
__device__ __forceinline__ void pv(f32x16*o,int vb,bf16x8 pa0,bf16x8 pa1,bf16x8 pa2,bf16x8 pa3){
  #pragma unroll
  for(int d0=0;d0<2;++d0){s16x4 lo[4],hi[4];
    #pragma unroll
    for(int ks=0;ks<4;++ks){
      asm volatile("ds_read_b64_tr_b16 %0,%1 offset:%c2":"=&v"(lo[ks]):"v"(vb),"i"(d0*4096+ks*1024):"memory");
      asm volatile("ds_read_b64_tr_b16 %0,%1 offset:%c2":"=&v"(hi[ks]):"v"(vb),"i"(d0*4096+ks*1024+512):"memory");}
    asm volatile("s_waitcnt lgkmcnt(0)":::"memory");SBAR();
    #define PK(k) (bf16x8){lo[k][0],lo[k][1],lo[k][2],lo[k][3],hi[k][0],hi[k][1],hi[k][2],hi[k][3]}
    o[d0]=__builtin_amdgcn_mfma_f32_32x32x16_bf16(pa0,PK(0),o[d0],0,0,0);
    o[d0]=__builtin_amdgcn_mfma_f32_32x32x16_bf16(pa1,PK(1),o[d0],0,0,0);
    o[d0]=__builtin_amdgcn_mfma_f32_32x32x16_bf16(pa2,PK(2),o[d0],0,0,0);
    o[d0]=__builtin_amdgcn_mfma_f32_32x32x16_bf16(pa3,PK(3),o[d0],0,0,0);
    #undef PK
  }
}

#ifndef ATTN_STORE16
#define ATTN_STORE16(p,v) (*(u32x4*)(p)=(v))
#endif
template<int THRL> __device__ __forceinline__ void attn_unit(int b,int h,int qb,const bf16*Q,const bf16*__restrict__ K,const bf16*__restrict__ V,bf16*O,char*shm){
  const int kvh=h>>2;
  const int tid=threadIdx.x,lane=tid&63,r32=lane&31,hi=lane>>5; const int wid=__builtin_amdgcn_readfirstlane(tid>>6);
  const long rowbase=(long)b*SEQQ, rowbasek=(long)b*SEQK; const int q0=qb*QB;
  const bf16*Qw=Q+(rowbase+q0+wid*QBLK)*QP+h*D;
  const bf16*Kh=K+rowbasek*KVP+kvh*D,*Vh=V+rowbasek*KVP+kvh*D;
  const unsigned lds0=(unsigned)(uintptr_t)shm;
  float*wsf=(float*)(shm+LDS_WS)+wid*64;
  const bf16*ksrc=Kh+(long)lane*KVP+wid*8;
  const bf16*vsrc=Vh+(long)(16*(wid&3)+(lane>>2))*KVP+(wid>>2)*32+(lane&3)*8;
  const unsigned kdst=lds0+LDS_K+wid*1024, vdst=lds0+LDS_V+wid*1024;
  #define DMA_K(t,slot) glds16(ksrc+(long)(t)*KVBLK*KVP,(unsigned)__builtin_amdgcn_readfirstlane(kdst+(slot)))
  #define DMA_V(t,slot) glds16(vsrc+(long)(t)*KVBLK*KVP,(unsigned)__builtin_amdgcn_readfirstlane(vdst+(slot)))
  const int vb0=(int)(lds0+LDS_V)+((lane>>4)&1)*32+(lane&3)*8+(4*hi+((lane&15)>>2))*64;
  const char*Kbase=shm+LDS_K; bf16x8 kf[8];
  const lds_cptr shm3=(lds_cptr)shm; const lds_cptr kp0=shm3+LDS_K+hi*1024+r32*16; const lds_cptr vp0=shm3+LDS_V+((lane>>4)&1)*32+(lane&3)*8+(4*hi+((lane&15)>>2))*64;
  constexpr int NT=SEQK/KVBLK;
  DMA_K(0,0);DMA_V(0,0);DMA_K(1,SLOTB);
  bf16x8 qr[4];
  #pragma unroll
  for(int d0=0;d0<4;++d0)qr[d0]=*reinterpret_cast<const bf16x8*>(&Qw[(long)r32*QP+d0*16+hi*8]);
  float mhat=0.f,l_reg=0.f;f32x16 o[2];o[0]=f32x16{};o[1]=f32x16{};f32x16 negm=f32x16{};asm volatile("":"+v"(negm));
  #define CMASK(P0,P1,t) do{}while(0)
  bool resc=false;
  #define START(P0,P1) do{ const float rm=rowmax(P0,P1); resc=false; \
    { const float dl=rm; mhat=fadd_s(mhat,dl); \
      _Pragma("unroll") for(int r=0;r<16;++r){P0[r]=fsub_s(P0[r],dl);P1[r]=fsub_s(P1[r],dl);} \
      _Pragma("unroll") for(int r=0;r<16;++r)negm[r]=-mhat; asm volatile("":"+v"(negm)); } \
    _Pragma("unroll") for(int r=0;r<16;++r)P0[r]=__builtin_amdgcn_exp2f(P0[r]); }while(0)
  #define RESC() do{ if(resc){ asm volatile("s_waitcnt lgkmcnt(0)":::"memory"); \
      _Pragma("unroll") for(int d_=0;d_<2;++d_) _Pragma("unroll") for(int r=0;r<16;++r)o[d_][r]*=wsf[crow(r,hi)]; } }while(0)
  f32x16 pA0,pA1,pB0,pB1;
  int sl_prev=0,sl_cur=0,sl_next=SLOTB;
  #define ROT() do{sl_prev=sl_cur;sl_cur=sl_next;sl_next=(sl_next==(NSLOT-1)*SLOTB)?0:sl_next+SLOTB;}while(0)
  DMA_K(2,2*SLOTB);
  WAIT_BAR(3);
  qkt(pA0,pA1,Kbase,qr,negm,r32,hi);asm volatile("s_nop 15\n\ts_nop 7":"+v"(pA0),"+v"(pA1));CMASK(pA0,pA1,0);
  START(pA0,pA1);
  _Pragma("unroll") for(int r=0;r<16;++r)pA1[r]=__builtin_amdgcn_exp2f(pA1[r]);
  WAIT_BAR(0);
  DMA_K(3,0);DMA_V(1,SLOTB);
  ROT();
  kload8(kf,kp0+sl_cur);
  WAIT_BAR(2);
  s16x4 vlo[8],vhi[8]; u32x4 pw0,pw1,pw2,pw3;
  #define PKW(P,B) cvtpk_s(P[B],P[B+1])
  #define PAF(k) __builtin_bit_cast(bf16x8,pw##k)
  #define VFR(i) (bf16x8){vlo[i][0],vlo[i][1],vlo[i][2],vlo[i][3],vhi[i][0],vhi[i][1],vhi[i][2],vhi[i][3]}
  #define PIN(x) asm volatile("":"+v"(x))
  #define MX3(a,b,c) __builtin_fmaxf(__builtin_fmaxf((a),(b)),(c))
  #define GAPA(MF,A0,A1,A2,A3,W0,W1,PW) do{ MF; sacc+=A0; sacc+=A1; sacc+=A2; sacc+=A3; PIN(sacc); W0; W1; PIN(PW); SBAR(); }while(0)
  #define EX(v) __builtin_amdgcn_exp2f(v)
  #define GAPB(MF,X,B) do{ MF; X[B]=EX(X[B]); X[B+1]=EX(X[B+1]); X[B+2]=EX(X[B+2]); X[B+3]=EX(X[B+3]); PIN(X); SBAR(); }while(0)
  #define VRD(i) do{ vlo[i]=vtr(vp_+(((i)>>2)*4096+((i)&3)*1024)); vhi[i]=vtr(vp_+(((i)>>2)*4096+((i)&3)*1024+512)); }while(0)
  #define KRD(G,j) do{ if(G){ kload2(kf,kp0+sl_next,j); SBAR(); } }while(0)
  #define STEP(C0,C1,P0,P1,t,GK,GV,GL) do{ SBAR(); \
    const lds_cptr vp_=vp0+sl_prev; \
    VRD(0); SBAR(); float sacc=(P0[0]+P0[1]); \
    GAPA(C0=__builtin_amdgcn_mfma_f32_32x32x16_bf16(kf[0],qr[0],negm,0,0,0), P0[2],P0[3],P0[4],P0[5],     pw0[0]=PKW(P0,0), pw0[1]=PKW(P0,2), pw0); \
    VRD(4); SBAR(); GAPA(C1=__builtin_amdgcn_mfma_f32_32x32x16_bf16(kf[1],qr[0],negm,0,0,0), P0[6],P0[7],P0[8],P0[9],     pw0[2]=PKW(P0,4), pw0[3]=PKW(P0,6), pw0); \
    VRD(1); SBAR(); GAPA(C0=__builtin_amdgcn_mfma_f32_32x32x16_bf16(kf[2],qr[1],C0,0,0,0),   P0[10],P0[11],P0[12],P0[13], pw1[0]=PKW(P0,8), pw1[1]=PKW(P0,10), pw1); \
    VRD(5); SBAR(); GAPA(C1=__builtin_amdgcn_mfma_f32_32x32x16_bf16(kf[3],qr[1],C1,0,0,0),   P0[14],P0[15],P1[0],P1[1],   pw1[2]=PKW(P0,12),pw1[3]=PKW(P0,14), pw1); \
    VRD(2); SBAR(); GAPA(C0=__builtin_amdgcn_mfma_f32_32x32x16_bf16(kf[4],qr[2],C0,0,0,0),   P1[2],P1[3],P1[4],P1[5],     pw2[0]=PKW(P1,0), pw2[1]=PKW(P1,2), pw2); \
    VRD(6); SBAR(); GAPA(C1=__builtin_amdgcn_mfma_f32_32x32x16_bf16(kf[5],qr[2],C1,0,0,0),   P1[6],P1[7],P1[8],P1[9],     pw2[2]=PKW(P1,4), pw2[3]=PKW(P1,6), pw2); \
    VRD(3); SBAR(); GAPA(C0=__builtin_amdgcn_mfma_f32_32x32x16_bf16(kf[6],qr[3],C0,0,0,0),   P1[10],P1[11],P1[12],P1[13], pw3[0]=PKW(P1,8), pw3[1]=PKW(P1,10), pw3); \
    VRD(7); SBAR(); GAPA(C1=__builtin_amdgcn_mfma_f32_32x32x16_bf16(kf[7],qr[3],C1,0,0,0),   P1[14],P1[15],0.f,0.f,       pw3[2]=PKW(P1,12),pw3[3]=PKW(P1,14), pw3); \
    l_reg+=sacc; \
    if(GK){DMA_K((t)+3,sl_cur);} if(GV){DMA_V((t)+1,sl_next);} \
    CMASK(C0,C1,t); \
    { float a=MX3(C0[0],C0[1],C1[0]),b=MX3(C0[2],C0[3],C1[1]); a=MX3(a,C1[2],C1[3]); \
      _Pragma("unroll") for(int r=4;r<16;r+=4){a=MX3(a,C0[r],C0[r+1]);b=MX3(b,C0[r+2],C0[r+3]);a=MX3(a,C1[r],C1[r+1]);b=MX3(b,C1[r+2],C1[r+3]);} \
      float rm=__builtin_fmaxf(a,b); { auto rr=__builtin_amdgcn_permlane32_swap(__float_as_uint(rm),__float_as_uint(rm),false,false); rm=__builtin_fmaxf(__uint_as_float(rr[0]),__uint_as_float(rr[1])); } \
      resc=false; \
      if(__builtin_expect(__any(rm>(float)THRL),0)){ const float dl=__builtin_fmaxf(rm,0.f); mhat+=dl; \
        _Pragma("unroll") for(int r=0;r<16;++r){C0[r]-=dl;C1[r]-=dl;} \
        _Pragma("unroll") for(int r=0;r<16;++r)negm[r]=-mhat; asm volatile("":"+v"(negm)); \
        const float f=__builtin_amdgcn_exp2f(-dl); l_reg*=f; if(hi==0)wsf[r32]=f; resc=true; } } \
    SBAR(); \
    GAPB(o[0]=__builtin_amdgcn_mfma_f32_32x32x16_bf16(PAF(0),VFR(0),o[0],0,0,0), C0,0); \
    GAPB(o[1]=__builtin_amdgcn_mfma_f32_32x32x16_bf16(PAF(0),VFR(4),o[1],0,0,0), C0,4); \
    KRD(GL,0); GAPB(o[0]=__builtin_amdgcn_mfma_f32_32x32x16_bf16(PAF(1),VFR(1),o[0],0,0,0), C0,8); \
    KRD(GL,1); GAPB(o[1]=__builtin_amdgcn_mfma_f32_32x32x16_bf16(PAF(1),VFR(5),o[1],0,0,0), C0,12); \
    KRD(GL,2); GAPB(o[0]=__builtin_amdgcn_mfma_f32_32x32x16_bf16(PAF(2),VFR(2),o[0],0,0,0), C1,0); \
    KRD(GL,3); GAPB(o[1]=__builtin_amdgcn_mfma_f32_32x32x16_bf16(PAF(2),VFR(6),o[1],0,0,0), C1,4); \
    GAPB(o[0]=__builtin_amdgcn_mfma_f32_32x32x16_bf16(PAF(3),VFR(3),o[0],0,0,0), C1,8); \
    GAPB(o[1]=__builtin_amdgcn_mfma_f32_32x32x16_bf16(PAF(3),VFR(7),o[1],0,0,0), C1,12); \
    }while(0)
  int t=1;
  #undef CMASK
  #define CMASK(P0,P1,t) do{}while(0)
  for(;t+5<NT;t+=2){
    STEP(pB0,pB1,pA0,pA1,t,true,true,true);     WAIT_BAR(2); RESC(); ROT();
    STEP(pA0,pA1,pB0,pB1,t+1,true,true,true);   WAIT_BAR(2); RESC(); ROT();
  }
  #undef CMASK
  #define CMASK(P0,P1,t) do{}while(0)
  #define ENDW(tt) do{ if((tt)+3<NT){WAIT_BAR(2);} else if((tt)+2<NT){WAIT_BAR(1);} else {WAIT_BAR(0);} }while(0)
  for(;t+1<NT;t+=2){
    STEP(pB0,pB1,pA0,pA1,t,(t+3<NT),(t+1<NT),(t+1<NT));       ENDW(t);   RESC(); ROT();
    STEP(pA0,pA1,pB0,pB1,t+1,(t+4<NT),(t+2<NT),(t+2<NT));     ENDW(t+1); RESC(); ROT();
  }
  STEP(pB0,pB1,pA0,pA1,NT-1,false,false,false); RESC();
  { float sacc=pB0[0]+pB0[1]; _Pragma("unroll") for(int r=2;r<16;++r)sacc+=pB0[r]; _Pragma("unroll") for(int r=0;r<16;++r)sacc+=pB1[r]; l_reg+=sacc;
    pw0=(u32x4){PKW(pB0,0),PKW(pB0,2),PKW(pB0,4),PKW(pB0,6)};pw1=(u32x4){PKW(pB0,8),PKW(pB0,10),PKW(pB0,12),PKW(pB0,14)};pw2=(u32x4){PKW(pB1,0),PKW(pB1,2),PKW(pB1,4),PKW(pB1,6)};pw3=(u32x4){PKW(pB1,8),PKW(pB1,10),PKW(pB1,12),PKW(pB1,14)};
    SBAR(); pv(o,vb0+sl_cur,PAF(0),PAF(1),PAF(2),PAF(3)); }
  #undef PKW
  #undef PAF
  #undef VFR
  #undef PIN
  #undef MX3
  #undef GAPA
  #undef GAPB
  #undef EX
  #undef VRD
  #undef KRD
  #undef STEP
  #undef ENDW
  {auto rr=__builtin_amdgcn_permlane32_swap(__float_as_uint(l_reg),__float_as_uint(l_reg),false,false);l_reg=__uint_as_float(rr[0])+__uint_as_float(rr[1]);}
  if(hi==0)wsf[32+r32]=l_reg;asm volatile("s_waitcnt lgkmcnt(0)":::"memory");
  float rli[16];
  #pragma unroll
  for(int r=0;r<16;++r)rli[r]=__builtin_amdgcn_rcpf(wsf[32+crow(r,hi)]);
  bf16*Ow=O+(rowbase+q0+wid*QBLK)*OP+h*D;
  { bf16*stg=(bf16*)(shm+LDS_OST)+wid*2048;
    #pragma unroll
    for(int r=0;r<16;++r){const int orow=crow(r,hi);
      #pragma unroll
      for(int d0=0;d0<2;++d0)stg[orow*64+d0*32+r32]=__float2bfloat16(o[d0][r]*rli[r]);}
    asm volatile("s_waitcnt lgkmcnt(0)":::"memory");
    #pragma unroll
    for(int i=0;i<4;++i){const int row=i*8+(lane>>3),ch=lane&7; const u32x4 v=*(const u32x4*)(stg+row*64+ch*8); ATTN_STORE16(Ow+(long)row*OP+ch*8,v);} }
  asm volatile("s_waitcnt lgkmcnt(0)\n\ts_barrier":::"memory");
  #undef DMA_K
  #undef DMA_V
  #undef CMASK
  #undef START
  #undef RESC
  #undef ROT
}
constexpr int ATTN_LDS_BYTES=LDS_BYTES;
struct AttnTensors { const bf16* Q; const bf16* K; const bf16* V; bf16* O; };
struct AttnUnit { int bh; int qb; };
struct StaticOrder {
  int vcu;
  __device__ __forceinline__ explicit StaticOrder(int grid,int block):vcu((block%8)*(grid/8)+block/8){}
  __device__ __forceinline__ bool next(int i,AttnUnit&u)const{ if(i>=4)return false; const int w=32*i+(vcu&31); u.bh=(vcu>>5)*8+(w>>4); u.qb=w&15; return true; }
  __device__ __forceinline__ void a_ready(const AttnUnit&)const{}
  __device__ __forceinline__ void done(const AttnUnit&)const{}
};
template<class Sched,int THRL=8> __device__ __forceinline__ void attn_phase(char*lds,const AttnTensors&T,const Sched&S){
  AttnUnit u;
  for(int i=0;S.next(i,u);++i){ S.a_ready(u); attn_unit<THRL>(u.bh>>3,u.bh&7,u.qb,T.Q,T.K,T.V,T.O,lds); S.done(u); }
}
#undef SBAR
#undef WAIT_BAR
}
constexpr int NWAVES = 8;
constexpr int RING_OFF = 0, RING_BYTES = 131072;
constexpr int ROPE_OFF = RING_BYTES;
constexpr int MISC_OFF = ROPE_OFF + 8192;
constexpr int LDS_BYTES = 147456;
#define LAS __attribute__((address_space(3)))
typedef unsigned v4u __attribute__((ext_vector_type(4)));
typedef float f32x4 __attribute__((ext_vector_type(4)));
#define LDS_WAIT() asm volatile("s_waitcnt lgkmcnt(0)" ::: "memory")

typedef short bf16x8_t __attribute__((ext_vector_type(8)));
struct Args { const float* in[22]; float* out; unsigned char* ws; int ph_lo, ph_hi; };

__device__ __forceinline__ void tr_item(const float* __restrict__ W, int ldw, int k0, int n0, bf16_t* WTrow0, int ldk, LAS float* scr, int lane) {
#pragma unroll 8
    for (int i = 0; i < 32; ++i) { const int kk = 2 * i + (lane >> 5); scr[kk * 33 + (lane & 31)] = W[(size_t)(k0 + kk) * ldw + n0 + (lane & 31)]; }
    LDS_WAIT(); asm volatile("" ::: "memory");
    const int c = lane & 7;
#pragma unroll
    for (int j = 0; j < 4; ++j) { const int n = (lane >> 3) + 8 * j; const LAS float* s = scr + (8 * c) * 33 + n;
        v4u o; o.x = pk2(s[0 * 33], s[1 * 33]); o.y = pk2(s[2 * 33], s[3 * 33]); o.z = pk2(s[4 * 33], s[5 * 33]); o.w = pk2(s[6 * 33], s[7 * 33]);
        *(v4u*)(WTrow0 + (size_t)n * ldk + k0 + 8 * c) = o; }
    LDS_WAIT(); asm volatile("" ::: "memory");
}
__device__ __forceinline__ int win_vc0(int n0) {
    if (n0 < 512) { const int head = n0 >> 6, dh = (n0 >> 5) & 1; return 256 * (head >> 2) + 128 * dh + 32 * (head & 3); }
    if (n0 < 640) { const int hh = (n0 - 512) >> 6, dh = ((n0 - 512) >> 5) & 1; return 512 + 128 * dh + 32 * hh; }
    if (n0 < 768) { const int hv = (n0 - 640) >> 6, dh = ((n0 - 640) >> 5) & 1; return 512 + 128 * dh + 32 * (hv + 2); }
    return n0;
}


constexpr int HQ_LD = 136, HK_LD = 72;
constexpr int HA_QT = 0, HA_KT = HA_QT + 64 * HQ_LD * 2, HA_KHT = HA_KT + 64 * HQ_LD * 2, HA_VT = HA_KHT + 128 * HK_LD * 2, HA_AM = HA_VT + 128 * HK_LD * 2, HA_QS = HA_AM + 64 * HK_LD * 2, HA_END = HA_QS + 4 * 128 * 4;
static_assert(HA_END <= 131072, "HGRN phase A LDS");
__device__ __forceinline__ float fexp_c(float x) { return __expf(fminf(x, 80.f)); }
__device__ __forceinline__ void hgrn_a_unit(int unit, const bf16_t* __restrict__ QR, bf16_t* GF, bf16_t* GB, const bf16_t* __restrict__ IV, bf16_t* ORF, bf16_t* ORB, bf16_t* UT, float* DEC, LAS unsigned char* lds, int tid) {
    const int c = unit % NCHUNK, dir = (unit / NCHUNK) & 1, h = (unit / (2 * NCHUNK)) & 3, b = unit / (8 * NCHUNK);
    const bool lat = c >= 4;
    const int d = tid & 127, qt = tid >> 7, lane = tid & 63, wave = __builtin_amdgcn_readfirstlane(tid >> 6), ln = lane & 15, lg = lane >> 4;
    bf16_t* G = dir ? GB : GF; bf16_t* OR = dir ? ORB : ORF;
    LAS bf16_t* Qt = (LAS bf16_t*)(lds + HA_QT); LAS bf16_t* Kt = (LAS bf16_t*)(lds + HA_KT); LAS bf16_t* KhT = (LAS bf16_t*)(lds + HA_KHT);
    LAS bf16_t* VT = (LAS bf16_t*)(lds + HA_VT); LAS bf16_t* Am = (LAS bf16_t*)(lds + HA_AM); LAS float* qs = (LAS float*)(lds + HA_QS);
    const size_t rowb = (size_t)b * TPB + 64 * c;
    float g[16], q[16]; unsigned vv[8];
#pragma unroll
    for (int i = 0; i < 16; ++i) {
        const int j = 16 * qt + i; const size_t off = (rowb + (dir ? 63 - j : j)) * 512 + h * 128 + d;
        g[i] = bf2f(G[off]); q[i] = bf2f(QR[off]);
        const unsigned iv = IV[off];
        if (i & 1) vv[i >> 1] |= iv << 16; else vv[i >> 1] = iv;
    }
    float bl[16]; float run = 0.f;
#pragma unroll
    for (int i = 0; i < 16; ++i) { run += g[i]; bl[i] = run; }
    qs[qt * 128 + d] = run;
    *(v4u*)(VT + d * HK_LD + 16 * qt) = (v4u){vv[0], vv[1], vv[2], vv[3]};
    *(v4u*)(VT + d * HK_LD + 16 * qt + 8) = (v4u){vv[4], vv[5], vv[6], vv[7]};
    __syncthreads();
    const float s0 = qs[d], s1 = qs[128 + d], s2 = qs[256 + d], s3 = qs[384 + d];
    const float bmid = s0 + s1, bend = bmid + s2 + s3;
    const float off = qt == 0 ? 0.f : (qt == 1 ? s0 : (qt == 2 ? bmid : bmid + s2));
    unsigned kh[8];
#pragma unroll
    for (int i = 0; i < 16; ++i) {
        const int j = 16 * qt + i; const float bb = off + bl[i];
        const float k = 1.f - __expf(g[i]);
        if (lat) G[(rowb + (dir ? 63 - j : j)) * 512 + h * 128 + d] = f2bf(q[i] * __expf(bb));
        Qt[j * HQ_LD + d] = f2bf(q[i] * fexp_c(bb - bmid));
        Kt[j * HQ_LD + d] = f2bf(k * fexp_c(bmid - bb));
        const unsigned kk = f2bf(k * __expf(bend - bb));
        if (i & 1) kh[i >> 1] |= kk << 16; else kh[i >> 1] = kk;
    }
    *(v4u*)(KhT + d * HK_LD + 16 * qt) = (v4u){kh[0], kh[1], kh[2], kh[3]};
    *(v4u*)(KhT + d * HK_LD + 16 * qt + 8) = (v4u){kh[4], kh[5], kh[6], kh[7]};
    if (qt == 0) DEC[(size_t)unit * 128 + d] = __expf(bend);
    __syncthreads();
    {
        const int jb = wave >> 1;
#pragma unroll
        for (int sbi = 0; sbi < 2; ++sbi) {
            const int sb = 2 * (wave & 1) + sbi;
            f32x4 acc = (f32x4){0.f, 0.f, 0.f, 0.f};
#pragma unroll
            for (int ks = 0; ks < 4; ++ks) {
                const bf16x8_t af = *(const LAS bf16x8_t*)(Qt + (16 * jb + ln) * HQ_LD + 32 * ks + 8 * lg);
                const bf16x8_t bf = *(const LAS bf16x8_t*)(Kt + (16 * sb + ln) * HQ_LD + 32 * ks + 8 * lg);
                acc = __builtin_amdgcn_mfma_f32_16x16x32_bf16(af, bf, acc, 0, 0, 0);
            }
#pragma unroll
            for (int rg = 0; rg < 4; ++rg) { const int j = 16 * jb + 4 * lg + rg, sidx = 16 * sb + ln; Am[j * HK_LD + sidx] = f2bf(sidx <= j ? acc[rg] : 0.f); }
        }
    }
    __syncthreads();
    {
        const int vb = wave;
        bf16x8_t vf[2];
#pragma unroll
        for (int ks = 0; ks < 2; ++ks) vf[ks] = *(const LAS bf16x8_t*)(VT + (16 * vb + ln) * HK_LD + 32 * ks + 8 * lg);
        if (lat) {
#pragma unroll
            for (int jb = 0; jb < 4; ++jb) {
                f32x4 acc = (f32x4){0.f, 0.f, 0.f, 0.f};
#pragma unroll
                for (int ks = 0; ks < 2; ++ks) { const bf16x8_t af = *(const LAS bf16x8_t*)(Am + (16 * jb + ln) * HK_LD + 32 * ks + 8 * lg); acc = __builtin_amdgcn_mfma_f32_16x16x32_bf16(af, vf[ks], acc, 0, 0, 0); }
#pragma unroll
                for (int rg = 0; rg < 4; ++rg) { const int j = 16 * jb + 4 * lg + rg; const size_t tok = (size_t)b * SEQ + 64 * (c - 4) + (dir ? 63 - j : j); OR[tok * 512 + h * 128 + 16 * vb + ln] = f2bf(acc[rg]); }
            }
        }
        bf16_t* ut = UT + (size_t)unit * 16384;
#pragma unroll
        for (int db = 0; db < 8; ++db) {
            f32x4 acc = (f32x4){0.f, 0.f, 0.f, 0.f};
#pragma unroll
            for (int ks = 0; ks < 2; ++ks) { const bf16x8_t bf = *(const LAS bf16x8_t*)(KhT + (16 * db + ln) * HK_LD + 32 * ks + 8 * lg); acc = __builtin_amdgcn_mfma_f32_16x16x32_bf16(vf[ks], bf, acc, 0, 0, 0); }
#pragma unroll
            for (int rg = 0; rg < 4; ++rg) ut[(16 * vb + 4 * lg + rg) * 128 + 16 * db + ln] = f2bf(acc[rg]);
        }
    }
    __syncthreads();
}
__device__ __forceinline__ void hgrn_b_chain(int id, const bf16_t* __restrict__ GF, const bf16_t* __restrict__ GB, bf16_t* ORF, bf16_t* ORB, const bf16_t* __restrict__ UT, const float* __restrict__ DEC, int tid) {
    const int sl = id & 3, dir = (id >> 2) & 1, h = (id >> 3) & 3, b = id >> 5;
    const int lane = tid & 63, wave = __builtin_amdgcn_readfirstlane(tid >> 6), ln = lane & 15, lg = lane >> 4, jb = wave >> 1, vb = wave & 1;
    const bf16_t* QH = dir ? GB : GF; bf16_t* OR = dir ? ORB : ORF;
    const int vg = 32 * sl + 16 * vb + ln;
    float S[4][8];
#pragma unroll
    for (int ks = 0; ks < 4; ++ks)
#pragma unroll
        for (int jj = 0; jj < 8; ++jj) S[ks][jj] = 0.f;
    const int ubase = ((b * 4 + h) * 2 + dir) * NCHUNK;
    for (int st = 0; st < NCHUNK; ++st) {
        const int c = dir == 0 ? st : (st < 4 ? 3 - st : 71 - st);
        const int unit = ubase + c;
        v4u u8[4]; f32x4 a8[4][2];
        const bf16_t* ut = UT + (size_t)unit * 16384 + (size_t)vg * 128 + 8 * lg;
        const float* dc = DEC + (size_t)unit * 128 + 8 * lg;
#pragma unroll
        for (int ks = 0; ks < 4; ++ks) { u8[ks] = *(const v4u*)(ut + 32 * ks); a8[ks][0] = *(const f32x4*)(dc + 32 * ks); a8[ks][1] = *(const f32x4*)(dc + 32 * ks + 4); }
        if (c >= 4) {
            const size_t rowq = (size_t)b * TPB + 64 * c + (dir ? 63 - (16 * jb + ln) : 16 * jb + ln);
            const bf16_t* qp = QH + rowq * 512 + h * 128 + 8 * lg;
            f32x4 acc = (f32x4){0.f, 0.f, 0.f, 0.f};
#pragma unroll
            for (int ks = 0; ks < 4; ++ks) {
                const bf16x8_t af = *(const bf16x8_t*)(qp + 32 * ks);
                v4u sb; sb.x = pg8::cvt_pk_bf16(S[ks][0], S[ks][1]); sb.y = pg8::cvt_pk_bf16(S[ks][2], S[ks][3]); sb.z = pg8::cvt_pk_bf16(S[ks][4], S[ks][5]); sb.w = pg8::cvt_pk_bf16(S[ks][6], S[ks][7]);
                acc = __builtin_amdgcn_mfma_f32_16x16x32_bf16(af, __builtin_bit_cast(bf16x8_t, sb), acc, 0, 0, 0);
            }
#pragma unroll
            for (int rg = 0; rg < 4; ++rg) {
                const int j = 16 * jb + 4 * lg + rg; const size_t tok = (size_t)b * SEQ + 64 * (c - 4) + (dir ? 63 - j : j);
                bf16_t* op = OR + tok * 512 + h * 128 + vg;
                *op = f2bf(acc[rg] + bf2f(*op));
            }
        }
#pragma unroll
        for (int ks = 0; ks < 4; ++ks) {
            const unsigned w[4] = {u8[ks].x, u8[ks].y, u8[ks].z, u8[ks].w};
#pragma unroll
            for (int p = 0; p < 4; ++p) {
                const float a0 = p < 2 ? a8[ks][0][2 * p] : a8[ks][1][2 * p - 4], a1 = p < 2 ? a8[ks][0][2 * p + 1] : a8[ks][1][2 * p - 3];
                S[ks][2 * p] = a0 * S[ks][2 * p] + __uint_as_float(w[p] << 16);
                S[ks][2 * p + 1] = a1 * S[ks][2 * p + 1] + __uint_as_float(w[p] & 0xffff0000u);
            }
        }
    }
}

__device__ __forceinline__ int build_tiles(const int* ctl, LAS int* segt, LAS int* tile_e, LAS int* cntl, int tid) {
    __syncthreads();
    if (tid < 64) {
        const int c = tid < 32 ? ctl[CT_CNT + tid] : 0, nt = (c + 255) >> 8;
        int p = nt;
#pragma unroll
        for (int o = 1; o < 32; o <<= 1) { const int t = __shfl_up(p, o); if (tid >= o) p += t; }
        const int start = p - nt;
        if (tid < 32) { segt[tid] = start; cntl[tid] = c; for (int i = 0; i < nt; ++i) tile_e[start + i] = tid; }
        if (tid == 31) segt[32] = p;
    }
    __syncthreads();
    return segt[32];
}

__global__ void __launch_bounds__(NWAVES * 64, 2) mk_fwd(Args a) {
    extern __shared__ __attribute__((aligned(16))) unsigned char lds[];
    cg::grid_group grid = cg::this_grid();
    const int tid = threadIdx.x, lane = tid & 63, wave = __builtin_amdgcn_readfirstlane(tid >> 6);
    const int G = gridDim.x, bx = blockIdx.x;
    unsigned char* ws = a.ws;
    const float* x = a.in[0]; const float* c = a.in[1]; const float* ctx = a.in[2]; const float* c_ctx = a.in[3];
    const float* w_ada = a.in[4]; const float* b_ada = a.in[5]; const float* norm1_g = a.in[6];
    const float* w_in = a.in[8]; const float* q_norm_g = a.in[9]; const float* k_norm_g = a.in[10];
    const float* hgrn_lb = a.in[12]; const float* w_out = a.in[14];
    const float* weg = a.in[19]; const float* weu = a.in[20]; const float* wed = a.in[21];
    float* mod = (float*)(ws + WS_MOD); float* lb = (float*)(ws + WS_MOD + 256 * 1024);
    bf16_t* WT_IN = (bf16_t*)(ws + WS_WTIN); bf16_t* WT_OUT = (bf16_t*)(ws + WS_WTOUT); bf16_t* WGU = (bf16_t*)(ws + WS_WGU); bf16_t* WDN = (bf16_t*)(ws + WS_WDN);
    bf16_t* H = (bf16_t*)(ws + WS_H);

    {
        LAS float* rt = (LAS float*)(lds + ROPE_OFF);
        for (int i = tid; i < 1024; i += NWAVES * 64) { const int pos = i >> 4, f = i & 15; const float ang = (float)pos * powf(10000.0f, -(float)f * (1.0f / 16.0f)); rt[2 * i] = cosf(ang); rt[2 * i + 1] = sinf(ang); }
    }
    const int ph_lo = a.ph_lo, ph_hi = a.ph_hi;
#define IN(k) (ph_lo <= (k) && (k) < ph_hi)
#define SEAM(k) do { if (IN(k) && IN((k) + 1)) grid.sync(); } while (0)
    __syncthreads();
    if (IN(0)) {
    if (bx < 192) {
        LAS float* s = (LAS float*)lds; LAS float* part = (LAS float*)(lds + 40960);
        for (int i = tid; i < 9 * 1024; i += NWAVES * 64) { const int r = i >> 10, k = i & 1023; const float v = r < 8 ? c[r * 1024 + k] : c_ctx[k]; s[i] = v / (1.f + expf(-v)); }
        __syncthreads();
        const int j = tid & 31, ks = tid >> 5, j0 = bx * 32;
        float acc[9];
#pragma unroll
        for (int r = 0; r < 9; ++r) acc[r] = 0.f;
#pragma unroll 8
        for (int kk = 0; kk < 64; ++kk) {
            const int k = ks * 64 + kk; const float w = w_ada[(size_t)k * 6144 + j0 + j];
#pragma unroll
            for (int r = 0; r < 9; ++r) acc[r] += s[r * 1024 + k] * w;
        }
#pragma unroll
        for (int r = 0; r < 9; ++r) part[(ks * 9 + r) * 32 + j] = acc[r];
        __syncthreads();
        if (tid < 288) { const int r = tid >> 5, jj = tid & 31; float sum = b_ada[j0 + jj];
            for (int q = 0; q < 16; ++q) sum += part[(q * 9 + r) * 32 + jj];
            mod[r * 6144 + j0 + jj] = sum; }
    }
    if (bx == G - 1) {
        for (int i = tid; i < 1024; i += NWAVES * 64) { const int d = i >> 9, w = i & 511; const float l0 = hgrn_lb[(d * 2 + 0) * 512 + w], l1 = hgrn_lb[(d * 2 + 1) * 512 + w]; lb[i] = 1.f / (1.f + expf(l1 - l0)); }
        bf16_t* WRT = (bf16_t*)(ws + WS_WRT);
        for (int i = tid; i < 48 * 1024; i += NWAVES * 64) { const int n = i >> 10, k = i & 1023; const float v = n < 4 ? a.in[15][k * 4 + n] : (n < 36 ? a.in[17][k * 32 + (n - 4)] : 0.f); WRT[i] = f2bf(v); }
    }
    __syncthreads();
    {
        LAS float* scr = (LAS float*)(lds + RING_OFF + wave * 16384);
        const int gw = bx * NWAVES + wave, NGW = G * NWAVES;
        constexpr int I_IN = 16 * 104, I_OUT = 16 * 32;
        for (int it = gw; it < I_IN + I_OUT; it += NGW) {
            int r = it;
            if (r < I_IN) { const int kb = r / 104, nb = r % 104; tr_item(w_in, PW, 64 * kb, 32 * nb, WT_IN + (size_t)win_vc0(32 * nb) * 1024, 1024, scr, lane); continue; } r -= I_IN;
            { const int kb = r / 32, nb = r % 32; tr_item(w_out, 1024, 64 * kb, 32 * nb, WT_OUT + (size_t)(32 * nb) * 1024, 1024, scr, lane); }
        }
    }
    }
    SEAM(0);
    if (IN(1)) {
        const int gw = bx * NWAVES + wave, NGW = G * NWAVES;
        for (int row = gw; row < NROW; row += NGW) {
            const int b = row / TPB, pos = row % TPB;
            const float* src = pos < CTX ? ctx + ((size_t)b * CTX + pos) * D : x + ((size_t)b * SEQ + (pos - CTX)) * D;
            const float* m = mod + (pos < CTX ? 8 : b) * 6144;
            f32x4 v[4]; float ss = 0.f;
#pragma unroll
            for (int j = 0; j < 4; ++j) { v[j] = *(const f32x4*)(src + 4 * lane + 256 * j); ss += (v[j][0] * v[j][0] + v[j][1] * v[j][1]) + (v[j][2] * v[j][2] + v[j][3] * v[j][3]); }
            const float rstd = rsqrtf(wave_sum(ss) * (1.f / D) + EPS);
#pragma unroll
            for (int j = 0; j < 4; ++j) {
                const int k = 4 * lane + 256 * j;
                const f32x4 g = *(const f32x4*)(norm1_g + k), sc = *(const f32x4*)(m + 1024 + k), sh = *(const f32x4*)(m + k);
                float o[4];
#pragma unroll
                for (int i = 0; i < 4; ++i) o[i] = v[j][i] * rstd * g[i] * (1.f + sc[i]) + sh[i];
                uint2 pk; pk.x = pk2(o[0], o[1]); pk.y = pk2(o[2], o[3]);
                *(uint2*)(H + (size_t)row * D + k) = pk;
            }
        }
    }
    SEAM(1);
    if (IN(2)) {
        pg8::Gemm g{H, WT_IN, NROW, PW, D}; pg8::StaticOrder S; S.init(NROW, PW, G, bx);
        pg8::EpiInproj E{(bf16_t*)(ws + WS_QA), (bf16_t*)(ws + WS_KA), (bf16_t*)(ws + WS_VA), (bf16_t*)(ws + WS_QR), (bf16_t*)(ws + WS_GF), (bf16_t*)(ws + WS_GB),
                         (bf16_t*)(ws + WS_IV), (bf16_t*)(ws + WS_GR), q_norm_g, k_norm_g, lb, (const LAS pg8::f32x2*)(lds + ROPE_OFF)};
        pg8::gemm_phase<pg8::EpiInproj, pg8::StaticOrder, true, true>((LAS unsigned char*)lds + RING_OFF, g, S, E);
    }
    SEAM(2);
    if (IN(3)) {
        static_assert(attn_body::ATTN_LDS_BYTES <= RING_BYTES, "attention LDS");
        const attn_body::AttnTensors AT{(const attn_body::bf16*)(ws + WS_QA), (const attn_body::bf16*)(ws + WS_KA), (const attn_body::bf16*)(ws + WS_VA), (attn_body::bf16*)(ws + WS_QA)};
        const attn_body::StaticOrder S(G, bx);
        attn_body::attn_phase<attn_body::StaticOrder>((char*)lds + RING_OFF, AT, S);
        __syncthreads();
        for (int unit = bx; unit < NHUNIT; unit += G)
            hgrn_a_unit(unit, (const bf16_t*)(ws + WS_QR), (bf16_t*)(ws + WS_GF), (bf16_t*)(ws + WS_GB), (const bf16_t*)(ws + WS_IV), (bf16_t*)(ws + WS_ORF), (bf16_t*)(ws + WS_ORB),
                        (bf16_t*)(ws + WS_UT), (float*)(ws + WS_DEC), (LAS unsigned char*)lds + RING_OFF, tid);
    }
    SEAM(3);
    if (IN(4)) {
        const int vcu = (G % 8 == 0) ? (bx % 8) * (G / 8) + bx / 8 : bx;
        for (int id = vcu; id < 256; id += G)
            hgrn_b_chain(id, (const bf16_t*)(ws + WS_GF), (const bf16_t*)(ws + WS_GB), (bf16_t*)(ws + WS_ORF), (bf16_t*)(ws + WS_ORB), (const bf16_t*)(ws + WS_UT), (const float*)(ws + WS_DEC), tid);
    }
    SEAM(4);
    if (IN(5)) {
        const float* ag = a.in[11]; const float* hgw = a.in[13];
        const bf16_t* OA = (const bf16_t*)(ws + WS_QA); const bf16_t* ORF = (const bf16_t*)(ws + WS_ORF); const bf16_t* ORB = (const bf16_t*)(ws + WS_ORB); const bf16_t* GR = (const bf16_t*)(ws + WS_GR);
        bf16_t* MIXIN = (bf16_t*)(ws + WS_MIXIN);
        const int gw = bx * NWAVES + wave, NGW = G * NWAVES;
        f32x4 agv[2], hgv[2];
#pragma unroll
        for (int i = 0; i < 2; ++i) { agv[i] = *(const f32x4*)(ag + 8 * lane + 4 * i); hgv[i] = *(const f32x4*)(hgw + 8 * lane + 4 * i); }
        for (int tok = gw; tok < NLAT; tok += NGW) {
            const v4u oa = *(const v4u*)(OA + (size_t)tok * 512 + 8 * lane), of = *(const v4u*)(ORF + (size_t)tok * 512 + 8 * lane), ob = *(const v4u*)(ORB + (size_t)tok * 512 + 8 * lane), gr = *(const v4u*)(GR + (size_t)tok * 512 + 8 * lane);
            const unsigned wa[4] = {oa.x, oa.y, oa.z, oa.w}, wf[4] = {of.x, of.y, of.z, of.w}, wb[4] = {ob.x, ob.y, ob.z, ob.w}, wg[4] = {gr.x, gr.y, gr.z, gr.w};
            float xa[8], xr[8], gg[8]; float sa = 0.f, sr = 0.f;
#pragma unroll
            for (int p = 0; p < 4; ++p) {
                xa[2 * p] = __uint_as_float(wa[p] << 16); xa[2 * p + 1] = __uint_as_float(wa[p] & 0xffff0000u);
                xr[2 * p] = __uint_as_float(wf[p] << 16) + __uint_as_float(wb[p] << 16); xr[2 * p + 1] = __uint_as_float(wf[p] & 0xffff0000u) + __uint_as_float(wb[p] & 0xffff0000u);
                gg[2 * p] = __uint_as_float(wg[p] << 16); gg[2 * p + 1] = __uint_as_float(wg[p] & 0xffff0000u);
                sa += xa[2 * p] * xa[2 * p] + xa[2 * p + 1] * xa[2 * p + 1]; sr += xr[2 * p] * xr[2 * p] + xr[2 * p + 1] * xr[2 * p + 1];
            }
            sa += __shfl_xor(sa, 1); sa += __shfl_xor(sa, 2); sa += __shfl_xor(sa, 4);
            sr += __shfl_xor(sr, 1); sr += __shfl_xor(sr, 2); sr += __shfl_xor(sr, 4); sr += __shfl_xor(sr, 8);
            const float ra = rsqrtf(sa * (1.f / 64.f) + EPS), rr = rsqrtf(sr * (1.f / 128.f) + EPS);
            v4u o1, o2;
            o1.x = pk2(xa[0] * ra * agv[0][0], xa[1] * ra * agv[0][1]); o1.y = pk2(xa[2] * ra * agv[0][2], xa[3] * ra * agv[0][3]); o1.z = pk2(xa[4] * ra * agv[1][0], xa[5] * ra * agv[1][1]); o1.w = pk2(xa[6] * ra * agv[1][2], xa[7] * ra * agv[1][3]);
            o2.x = pk2(xr[0] * rr * hgv[0][0] * gg[0], xr[1] * rr * hgv[0][1] * gg[1]); o2.y = pk2(xr[2] * rr * hgv[0][2] * gg[2], xr[3] * rr * hgv[0][3] * gg[3]);
            o2.z = pk2(xr[4] * rr * hgv[1][0] * gg[4], xr[5] * rr * hgv[1][1] * gg[5]); o2.w = pk2(xr[6] * rr * hgv[1][2] * gg[6], xr[7] * rr * hgv[1][3] * gg[7]);
            *(v4u*)(MIXIN + (size_t)tok * 1024 + 8 * lane) = o1;
            *(v4u*)(MIXIN + (size_t)tok * 1024 + 512 + 8 * lane) = o2;
        }
    }
    SEAM(5);
    if (IN(6)) {
        pg8::Gemm g{(const bf16_t*)(ws + WS_MIXIN), WT_OUT, NLAT, D, D}; pg8::StaticOrder S; S.init(NLAT, D, G, bx);
        pg8::EpiOutproj E{x, mod, a.out};
        pg8::gemm_phase<pg8::EpiOutproj, pg8::StaticOrder, true, true>((LAS unsigned char*)lds + RING_OFF, g, S, E);
    }
    SEAM(6);
    LAS int* segt = (LAS int*)(lds + MISC_OFF); LAS int* tile_e = (LAS int*)(lds + MISC_OFF + 256); LAS int* cntl = (LAS int*)(lds + MISC_OFF + 2048);
    int* ctl = (int*)(ws + WS_CTL);
    float* ew = (float*)(ws + WS_RT); int* sel = (int*)(ws + WS_SEL); int* smap = (int*)(ws + WS_SMAP);
    bf16_t* H2 = (bf16_t*)(ws + WS_H2M); bf16_t* H2S = (bf16_t*)(ws + WS_H2S); bf16_t* ACT2 = (bf16_t*)(ws + WS_ACT2); bf16_t* YS2 = (bf16_t*)(ws + WS_YS2);
    if (IN(7)) {
        const float* norm2_g = a.in[7]; const float* brg = a.in[16]; const float* bre = a.in[18];
        const bf16_t* WRT = (const bf16_t*)(ws + WS_WRT);
        LAS float* lg = (LAS float*)(lds + wave * 4096);
        const int gw = bx * NWAVES + wave, NGW = G * NWAVES;
        for (int task = gw; task < NLAT / 16; task += NGW) {
            const int tok0 = task * 16; const float* m = mod + (tok0 / SEQ) * 6144;
            f32x4 ga[4], sh[4];
#pragma unroll
            for (int j = 0; j < 4; ++j) { const int k = 4 * lane + 256 * j; const f32x4 g = *(const f32x4*)(norm2_g + k), sc = *(const f32x4*)(m + 4096 + k); sh[j] = *(const f32x4*)(m + 3072 + k); ga[j] = g * (1.f + sc); }
            for (int r = 0; r < 16; ++r) {
                const float* src = a.out + (size_t)(tok0 + r) * D;
                f32x4 v[4]; float ss = 0.f;
#pragma unroll
                for (int j = 0; j < 4; ++j) { v[j] = *(const f32x4*)(src + 4 * lane + 256 * j); ss += (v[j][0] * v[j][0] + v[j][1] * v[j][1]) + (v[j][2] * v[j][2] + v[j][3] * v[j][3]); }
                const float rstd = rsqrtf(wave_sum(ss) * (1.f / D) + EPS);
#pragma unroll
                for (int j = 0; j < 4; ++j) { const f32x4 o = v[j] * rstd * ga[j] + sh[j]; uint2 pk; pk.x = pk2(o[0], o[1]); pk.y = pk2(o[2], o[3]); *(uint2*)(H2 + (size_t)(tok0 + r) * D + 4 * lane + 256 * j) = pk; }
            }
            asm volatile("s_waitcnt vmcnt(0)" ::: "memory");
            f32x4 acc[3];
#pragma unroll
            for (int nt = 0; nt < 3; ++nt) acc[nt] = (f32x4){0.f, 0.f, 0.f, 0.f};
            const bf16_t* arow = H2 + (size_t)(tok0 + (lane & 15)) * D + 8 * (lane >> 4);
            const bf16_t* brow = WRT + (size_t)(lane & 15) * D + 8 * (lane >> 4);
#pragma unroll 4
            for (int s = 0; s < 32; ++s) {
                const bf16x8_t af = *(const bf16x8_t*)(arow + 32 * s);
#pragma unroll
                for (int nt = 0; nt < 3; ++nt) { const bf16x8_t bf = *(const bf16x8_t*)(brow + (size_t)nt * 16 * D + 32 * s); acc[nt] = __builtin_amdgcn_mfma_f32_16x16x32_bf16(af, bf, acc[nt], 0, 0, 0); }
            }
#pragma unroll
            for (int nt = 0; nt < 3; ++nt)
#pragma unroll
                for (int rg = 0; rg < 4; ++rg) lg[(4 * (lane >> 4) + rg) * 48 + 16 * nt + (lane & 15)] = acc[nt][rg];
            asm volatile("s_waitcnt lgkmcnt(0)" ::: "memory");
            if (lane < 16) {
                const LAS float* l = lg + lane * 48; const int tok = tok0 + lane;
                float lgp[4]; int gs = 0; float gm = -1e30f;
#pragma unroll
                for (int g = 0; g < 4; ++g) { lgp[g] = l[g] + brg[g]; if (lgp[g] > gm) { gm = lgp[g]; gs = g; } }
                float z = 0.f;
#pragma unroll
                for (int g = 0; g < 4; ++g) z += __expf(lgp[g] - gm);
                const float pg = 1.f / z;
                int e1 = 0, e2 = 0; float m1 = -1e30f, m2 = -1e30f;
                for (int j = 0; j < 8; ++j) { const float v = l[4 + gs * 8 + j] + bre[gs * 8 + j]; if (v > m1) { m2 = m1; e2 = e1; m1 = v; e1 = j; } else if (v > m2) { m2 = v; e2 = j; } }
                const float rr = __expf(m2 - m1);
                const float w1 = pg / (1.f + rr), w2 = pg * rr / (1.f + rr);
                const int E1 = gs * 8 + e1, E2 = gs * 8 + e2;
                ew[tok * 2] = w1; ew[tok * 2 + 1] = w2;
                const int r1 = atomicAdd(&ctl[CT_CNT + E1], 1), r2 = atomicAdd(&ctl[CT_CNT + E2], 1);
                sel[tok * 2] = (E1 << 20) | r1; sel[tok * 2 + 1] = (E2 << 20) | r2;
            }
            asm volatile("s_waitcnt lgkmcnt(0)" ::: "memory");
        }
        __syncthreads();
        {
            LAS float* scr = (LAS float*)(lds + RING_OFF + wave * 16384);
            constexpr int I_G = 32 * 256, I_U = 32 * 256, I_D = 32 * 256;
            for (int it = gw; it < I_G + I_U + I_D; it += NGW) {
                int r = it;
                if (r < I_G) { const int e = r >> 8, q = r & 255, kb = q >> 4, nb = q & 15, n0 = 32 * nb;
                    tr_item(weg + (size_t)e * 1024 * 512, 512, 64 * kb, n0, WGU + ((size_t)e * 1024 + 256 * (n0 >> 7) + (n0 & 127)) * 1024, 1024, scr, lane); continue; } r -= I_G;
                if (r < I_U) { const int e = r >> 8, q = r & 255, kb = q >> 4, nb = q & 15, n0 = 32 * nb;
                    tr_item(weu + (size_t)e * 1024 * 512, 512, 64 * kb, n0, WGU + ((size_t)e * 1024 + 256 * (n0 >> 7) + 128 + (n0 & 127)) * 1024, 1024, scr, lane); continue; } r -= I_U;
                { const int e = r >> 8, q = r & 255, kb = q >> 5, nb = q & 31;
                    tr_item(wed + (size_t)e * 512 * 1024, 1024, 64 * kb, 32 * nb, WDN + ((size_t)e * 1024 + 32 * nb) * 512, 512, scr, lane); }
            }
        }
    }
    SEAM(7);
    if (IN(8)) {
        build_tiles(ctl, segt, tile_e, cntl, tid);
        const int gw = bx * NWAVES + wave, NGW = G * NWAVES;
        for (int tok = gw; tok < NLAT; tok += NGW) {
            const int s0 = sel[2 * tok], s1 = sel[2 * tok + 1];
            const int slot0 = segt[s0 >> 20] * 256 + (s0 & 0xFFFFF), slot1 = segt[s1 >> 20] * 256 + (s1 & 0xFFFFF);
            const v4u* src = (const v4u*)(H2 + (size_t)tok * D);
            const v4u v0 = src[lane], v1 = src[64 + lane];
            v4u* d0 = (v4u*)(H2S + (size_t)slot0 * D); v4u* d1 = (v4u*)(H2S + (size_t)slot1 * D);
            d0[lane] = v0; d0[64 + lane] = v1; d1[lane] = v0; d1[64 + lane] = v1;
            if (lane == 0) { smap[slot0] = 2 * tok; smap[slot1] = 2 * tok + 1; }
        }
    }
    SEAM(8);
    if (IN(9)) {
        const int ntl = build_tiles(ctl, segt, tile_e, cntl, tid);
        pg8::Gemm g{H2S, WGU, 0, 0, D}; pg8::GroupSched S{tile_e, ntl * 4, G, bx, (size_t)1024 * 1024 * 2};
        pg8::EpiMoe1 E{ACT2};
        pg8::gemm_phase<pg8::EpiMoe1, pg8::GroupSched, true, true>((LAS unsigned char*)lds + RING_OFF, g, S, E);
    }
    SEAM(9);
    if (IN(10)) {
        const int ntl = build_tiles(ctl, segt, tile_e, cntl, tid);
        pg8::Gemm g{ACT2, WDN, 0, 0, FFE}; pg8::GroupSched S{tile_e, ntl * 4, G, bx, (size_t)1024 * 512 * 2};
        pg8::EpiMoe2 E{YS2, smap, ew, tile_e, segt, cntl};
        pg8::gemm_phase<pg8::EpiMoe2, pg8::GroupSched, true, true>((LAS unsigned char*)lds + RING_OFF, g, S, E);
    }
    SEAM(10);
    if (IN(11)) {
        const int gw = bx * NWAVES + wave, NGW = G * NWAVES;
        for (int tok = gw; tok < NLAT; tok += NGW) {
            const float* m = mod + (tok / SEQ) * 6144 + 5120;
            float* o = a.out + (size_t)tok * D;
            const bf16_t* y0 = YS2 + (size_t)(2 * tok) * D; const bf16_t* y1 = y0 + D;
#pragma unroll
            for (int j = 0; j < 4; ++j) {
                const int k = 4 * lane + 256 * j;
                f32x4 v = *(const f32x4*)(o + k); const f32x4 gt = *(const f32x4*)(m + k);
                const uint2 p = *(const uint2*)(y0 + k), q = *(const uint2*)(y1 + k);
                v[0] += gt[0] * (__uint_as_float(p.x << 16) + __uint_as_float(q.x << 16));
                v[1] += gt[1] * (__uint_as_float(p.x & 0xffff0000u) + __uint_as_float(q.x & 0xffff0000u));
                v[2] += gt[2] * (__uint_as_float(p.y << 16) + __uint_as_float(q.y << 16));
                v[3] += gt[3] * (__uint_as_float(p.y & 0xffff0000u) + __uint_as_float(q.y & 0xffff0000u));
                *(f32x4*)(o + k) = v;
            }
        }
    }
#undef IN
#undef SEAM
}
extern "C" void kernel_launch(void* const* d_in, const int* in_sizes, int n_in, void* d_out, int out_size, void* d_ws, size_t ws_size, hipStream_t stream) {
    static int grid = 0;
    if (grid == 0) {
        if (n_in != 22 || ws_size < WS_END) { fprintf(stderr, "kernel_launch: unexpected n_in %d / ws_size %zu\n", n_in, ws_size); grid = -1; return; }
        int dev = 0, cus = 0, per_cu = 0;
        if (hipGetDevice(&dev) != hipSuccess || hipDeviceGetAttribute(&cus, hipDeviceAttributeMultiprocessorCount, dev) != hipSuccess) { grid = -1; return; }
        if (hipFuncSetAttribute((const void*)mk_fwd, hipFuncAttributeMaxDynamicSharedMemorySize, LDS_BYTES) != hipSuccess) { fprintf(stderr, "kernel_launch: hipFuncSetAttribute failed\n"); grid = -1; return; }
        if (hipOccupancyMaxActiveBlocksPerMultiprocessor(&per_cu, (const void*)mk_fwd, NWAVES * 64, LDS_BYTES) != hipSuccess || per_cu < 1) { fprintf(stderr, "kernel_launch: occupancy query says %d\n", per_cu); per_cu = 1; }
        (void)hipGetLastError();
        grid = cus;
        fprintf(stderr, "kernel_launch: cus %d per_cu %d grid %d\n", cus, per_cu, grid);
    }
    if (grid < 0) return;
    float* out = (float*)d_out;
    unsigned char* ws = (unsigned char*)d_ws;
    int* ctl = (int*)(ws + WS_CTL);
    (void)hipMemsetAsync(ctl, 0, 1 * MiB, stream);
    Args a{};
    for (int i = 0; i < 22; ++i) a.in[i] = (const float*)d_in[i];
    a.out = out; a.ws = ws;
    void* kargs[] = {&a};
    a.ph_lo = 0; a.ph_hi = 12;
    hipError_t le = hipLaunchCooperativeKernel((const void*)mk_fwd, dim3(grid), dim3(NWAVES * 64), kargs, LDS_BYTES, stream);
    if (le != hipSuccess) fprintf(stderr, "kernel_launch: cooperative launch failed: %s\n", hipGetErrorString(le));
}
```

```cpp
#include <hip/hip_runtime.h>
#include <hip/hip_cooperative_groups.h>
#include <cstdio>
#include <cstdint>
namespace cg = cooperative_groups;

typedef unsigned short bf16_t;
__device__ __forceinline__ float bf2f(bf16_t v) { return __uint_as_float(((unsigned)v) << 16); }
typedef float f32x2_c __attribute__((ext_vector_type(2))); typedef __bf16 bf16x2_c __attribute__((ext_vector_type(2)));
__device__ __forceinline__ unsigned pk2(float lo, float hi) { f32x2_c v = {lo, hi}; bf16x2_c b = __builtin_convertvector(v, bf16x2_c); return __builtin_bit_cast(unsigned, b); }
__device__ __forceinline__ bf16_t f2bf(float f) { return (bf16_t)(pk2(f, 0.f) & 0xffffu); }

constexpr int D = 1024, NB = 8, SEQ = 4096, CTX = 256, TPB = SEQ + CTX;
constexpr int NROW = NB * TPB;
constexpr int NLAT = NB * SEQ;
constexpr int PW = 3328;
constexpr int NEXP = 32, FFE = 512;
constexpr float EPS = 1e-6f;
constexpr int LISTCAP = NLAT;
constexpr int MAXTILES = 65536 / 64 + 32;
constexpr float C2 = 0.125f * 1.4426950408889634f;

constexpr size_t MiB = 1ull << 20;
constexpr size_t WS_CTL = 0;
constexpr size_t WS_MOD = 1 * MiB;
constexpr size_t WS_WRT = 1 * MiB + 512 * 1024;
constexpr size_t WS_WTIN = 2 * MiB;
constexpr size_t WS_WTOUT = 9 * MiB;
constexpr size_t WS_UT = 11 * MiB;
constexpr size_t WS_DEC = 147 * MiB;
constexpr size_t WS_H = 107 * MiB;
constexpr size_t WS_QA = 175 * MiB;
constexpr size_t WS_KA = 207 * MiB;
constexpr size_t WS_VA = 216 * MiB;
constexpr size_t WS_QR = 225 * MiB;
constexpr size_t WS_GF = 259 * MiB;
constexpr size_t WS_GB = 293 * MiB;
constexpr size_t WS_IV = 327 * MiB;
constexpr size_t WS_GR = 361 * MiB;
constexpr size_t WS_ORF = 393 * MiB, WS_ORB = 425 * MiB;
constexpr size_t WS_RT = 489 * MiB;
constexpr size_t WS_LIST = WS_RT + 256 * 1024;
constexpr size_t WS_END = 494 * MiB;
constexpr size_t WS_MIXIN = 11 * MiB;
constexpr size_t WS_H2M = 107 * MiB;
constexpr size_t WS_H2S = 175 * MiB;
constexpr size_t WS_ACT2 = 11 * MiB;
constexpr size_t WS_DL = 225 * MiB;
constexpr size_t OUT_WGU = 0, OUT_WDN = 64 * MiB;
constexpr size_t WS_YS2 = 361 * MiB;
constexpr int MAXT256 = 65536 / 256 + 32;
constexpr int NCHUNK = TPB / 64;
constexpr int NHUNIT = NB * 4 * 2 * NCHUNK;

constexpr int CT_CNT = 0, CT_NT = 32, CT_TE = 64, CT_TI = CT_TE + MAXTILES, CT_TS = CT_TI + MAXTILES;

__device__ __forceinline__ float wave_sum(float v) {
#pragma unroll
    for (int o = 32; o >= 1; o >>= 1) v += __shfl_xor(v, o);
    return v;
}
__device__ __forceinline__ float half_sum(float v) {
#pragma unroll
    for (int o = 16; o >= 1; o >>= 1) v += __shfl_xor(v, o);
    return v;
}

constexpr float FP8_SC = 32.f, FP8_ISC = 1.f / 32.f;
__device__ __forceinline__ unsigned pack4_fp8(float a, float b, float c, float d) {
    a = fminf(fmaxf(a * FP8_SC, -448.f), 448.f); b = fminf(fmaxf(b * FP8_SC, -448.f), 448.f); c = fminf(fmaxf(c * FP8_SC, -448.f), 448.f); d = fminf(fmaxf(d * FP8_SC, -448.f), 448.f);
    int w = __builtin_amdgcn_cvt_pk_fp8_f32(a, b, 0, false); w = __builtin_amdgcn_cvt_pk_fp8_f32(c, d, w, true); return (unsigned)w;
}
typedef float f32x2_u __attribute__((ext_vector_type(2)));
__device__ __forceinline__ void unpack4_fp8(unsigned w, float (&o)[4]) {
    const f32x2_u lo = __builtin_amdgcn_cvt_pk_f32_fp8((int)w, false), hi = __builtin_amdgcn_cvt_pk_f32_fp8((int)w, true);
    o[0] = lo.x * FP8_ISC; o[1] = lo.y * FP8_ISC; o[2] = hi.x * FP8_ISC; o[3] = hi.y * FP8_ISC;
}
namespace pg8 {
#define PG8_LAS __attribute__((address_space(3)))
typedef unsigned short bf16_t;
typedef short bf16x8 __attribute__((ext_vector_type(8)));
typedef float f32x4 __attribute__((ext_vector_type(4)));
typedef unsigned u32x4 __attribute__((ext_vector_type(4)));
constexpr int BM = 256, BK = 64, HALF = 128, HTB = HALF * BK * 2  , STAGE_BYTES = 8 * HTB, NXCD = 8, WGM = 8;

__host__ __device__ __forceinline__ int lds_byte(int r, int c) { const int st = (r >> 4) * 2 + (c >> 5), rr = r & 15, cc = c & 31, ob = rr * 64 + cc * 2; return st * 1024 + (ob ^ (((ob >> 9) & 1) << 5)); }
__host__ __device__ __forceinline__ void stage_rc(int b, int& R, int& C) { const int st = b / 1024, sb = b % 1024, swz = sb ^ (((sb >> 9) & 1) << 5); R = (st >> 1) * 16 + swz / 64; C = (st & 1) * 32 + (swz % 64) / 2; }
__host__ __device__ __forceinline__ int perm32(int rho) { const int n = rho >> 4, i = rho & 15; return 8 * (i >> 2) + 4 * n + (i & 3); }

struct Unit { int pm, pn; };
struct Gemm { const bf16_t* A; const bf16_t* Bt; int M, N, K; int lda = 0; int nsplit = 1 << 30; long adelta = 0; };

struct StaticOrder {
    static constexpr bool GATHER = false;
    __device__ __forceinline__ int arow(int, int) const { return 0; }
    int nM, nN, nwg, G, c;
    __host__ __device__ void init(int M, int N, int G_, int c_) { nM = M / BM; nN = N / BM; nwg = nM * nN; G = G_; c = c_; }
    __host__ __device__ bool next(int i, Unit& u) const {
        const long L = (long)i * G + c; if (L >= nwg) return false;
        int wgid = (int)L; { const int q = nwg / NXCD, r = nwg % NXCD, xcd = wgid % NXCD, off = wgid / NXCD; wgid = (xcd < r ? xcd * (q + 1) : r * (q + 1) + (xcd - r) * q) + off; }
        const int nig = WGM * nN, gid = wgid / nig, fm = gid * WGM, gsz = (nM - fm) < WGM ? (nM - fm) : WGM;
        u.pm = fm + ((wgid % nig) % gsz); u.pn = (wgid % nig) / gsz; return true;
    }
    __device__ __forceinline__ const char* aptr(const Gemm& g, const Unit& u, size_t tstep) const { return (const char*)g.A + (size_t)u.pm * tstep; }
    __device__ __forceinline__ const char* bptr(const Gemm& g, const Unit& u, size_t tstep) const { return (const char*)g.Bt + (size_t)u.pn * tstep; }
    __device__ __forceinline__ void a_ready(const Unit&) const {}
    __device__ __forceinline__ void done(const Unit&) const {}
};
__device__ __forceinline__ unsigned cvt_pk_bf16(float lo, float hi) { unsigned r; asm volatile("v_cvt_pk_bf16_f32 %0, %1, %2" : "=v"(r) : "v"(lo), "v"(hi)); return r; }
typedef float f32x2 __attribute__((ext_vector_type(2)));
typedef unsigned u32x2 __attribute__((ext_vector_type(2)));
__device__ __forceinline__ float fsigmoid(float x) { return __builtin_amdgcn_rcpf(1.f + __expf(-x)); }

struct EpiInproj {
    static constexpr bool PERM = true, AFTER_DRAIN = false;
    bf16_t *QA, *KA, *VA, *QR, *GF, *GB, *IV, *GR; const PG8_LAS float *qg, *kg, *lb; const PG8_LAS f32x2* rope;
    __device__ __forceinline__ void operator()(const f32x4 (&acc)[2][2][4][2], const Unit& u, int wr, int wc, int fr, int fq) const {
        const int pn = u.pn, pmb = u.pm / 17, pmr = u.pm % 17;
        const bool isctx = (pmr == 0);
        if (pn <= 2) {
            const bool isV = (pn == 2) && (wc >= 2);
            if (pn < 2 && isctx) return;
            float gv[2][2][4];
            const PG8_LAS float* gsrc = pn < 2 ? qg : kg;
#pragma unroll
            for (int bj = 0; bj < 2; ++bj)
#pragma unroll
                for (int n = 0; n < 2; ++n) { const f32x4 t = *(const PG8_LAS f32x4*)(gsrc + 32 * bj + 8 * fq + 4 * n); gv[bj][n][0] = t[0]; gv[bj][n][1] = t[1]; gv[bj][n][2] = t[2]; gv[bj][n][3] = t[3]; }
            const float osc = pn < 2 ? C2 : 1.0f;
#pragma unroll
            for (int ai = 0; ai < 2; ++ai)
#pragma unroll
                for (int m = 0; m < 4; ++m) {
                    const int rl = 128 * ai + 64 * wr + 16 * m + fr;
                    const size_t grow = (size_t)u.pm * 256 + rl;
                    f32x4 v[2][2];
#pragma unroll
                    for (int bj = 0; bj < 2; ++bj)
#pragma unroll
                        for (int n = 0; n < 2; ++n) v[bj][n] = acc[ai][bj][m][n];
                    if (!isV) {
                        float ss = 0.f;
#pragma unroll
                        for (int bj = 0; bj < 2; ++bj)
#pragma unroll
                            for (int n = 0; n < 2; ++n) ss += (v[bj][n][0] * v[bj][n][0] + v[bj][n][1] * v[bj][n][1]) + (v[bj][n][2] * v[bj][n][2] + v[bj][n][3] * v[bj][n][3]);
                        ss += __shfl_xor(ss, 16); ss += __shfl_xor(ss, 32);
                        const float rstd = rsqrtf(ss * (1.f / 64.f) + EPS) * osc;
                        const int ri = 4 * (pmr - 1) + 2 * ai + wr, ci = 16 * m + fr;
#pragma unroll
                        for (int bj = 0; bj < 2; ++bj) {
                            const int posv = bj ? ci : ri;
#pragma unroll
                            for (int n = 0; n < 2; ++n)
#pragma unroll
                                for (int p = 0; p < 2; ++p) {
                                    f32x2 cs = (f32x2){1.f, 0.f};
                                    if (!isctx) cs = rope[posv * 16 + 4 * fq + 2 * n + p];
                                    const float x1 = v[bj][n][2 * p] * rstd * gv[bj][n][2 * p], x2 = v[bj][n][2 * p + 1] * rstd * gv[bj][n][2 * p + 1];
                                    v[bj][n][2 * p] = x1 * cs.x - x2 * cs.y; v[bj][n][2 * p + 1] = x1 * cs.y + x2 * cs.x;
                                }
                        }
                    }
                    bf16_t* dst;
                    if (pn < 2) dst = QA + ((size_t)pmb * SEQ + (size_t)(pmr - 1) * 256 + rl) * 512 + (4 * pn + wc) * 64 + 8 * fq;
                    else if (!isV) dst = KA + grow * 128 + wc * 64 + 8 * fq;
                    else dst = VA + grow * 128 + (wc - 2) * 64 + 8 * fq;
#pragma unroll
                    for (int bj = 0; bj < 2; ++bj) {
                        u32x4 w; w.x = cvt_pk_bf16(v[bj][0][0], v[bj][0][1]); w.y = cvt_pk_bf16(v[bj][0][2], v[bj][0][3]); w.z = cvt_pk_bf16(v[bj][1][0], v[bj][1][1]); w.w = cvt_pk_bf16(v[bj][1][2], v[bj][1][3]);
                        *(u32x4*)(dst + 32 * bj) = w;
                    }
                }
            return;
        }
        const int seg = pn <= 4 ? 0 : (pn <= 8 ? 1 : (pn <= 10 ? 2 : 3));
        if (seg == 3 && isctx) return;
        int cb; bf16_t* base; int dir = 0;
        if (seg == 0) { cb = 256 * (pn - 3); base = QR; }
        else if (seg == 1) { dir = (pn - 5) >> 1; cb = 256 * ((pn - 5) & 1); base = dir ? GB : GF; }
        else if (seg == 2) { cb = 256 * (pn - 9); base = IV; }
        else { cb = 256 * (pn - 11); base = GR; }
        const int c0 = cb + 32 * wc + 8 * fq;
        f32x4 lbv[2][2];
        if (seg == 1) {
#pragma unroll
            for (int bj = 0; bj < 2; ++bj)
#pragma unroll
                for (int n = 0; n < 2; ++n) lbv[bj][n] = *(const PG8_LAS f32x4*)(lb + dir * 512 + c0 + 128 * bj + 4 * n);
        }
#pragma unroll
        for (int ai = 0; ai < 2; ++ai)
#pragma unroll
            for (int m = 0; m < 4; ++m) {
                const int rl = 128 * ai + 64 * wr + 16 * m + fr;
                const size_t drow = seg == 3 ? ((size_t)pmb * SEQ + (size_t)(pmr - 1) * 256 + rl) : ((size_t)u.pm * 256 + rl);
                bf16_t* dst = base + drow * 512 + c0;
#pragma unroll
                for (int bj = 0; bj < 2; ++bj) {
                    f32x4 v0 = acc[ai][bj][m][0], v1 = acc[ai][bj][m][1];
                    if (seg == 0) {
#pragma unroll
                        for (int i = 0; i < 4; ++i) { v0[i] = v0[i] * fsigmoid(v0[i]) * 0.08838834764831845f; v1[i] = v1[i] * fsigmoid(v1[i]) * 0.08838834764831845f; }
                    } else if (seg == 1) {
#pragma unroll
                        for (int i = 0; i < 4; ++i) { const float l0 = lbv[bj][0][i], l1 = lbv[bj][1][i]; v0[i] = __logf(l0 + (1.f - l0) * fsigmoid(v0[i])); v1[i] = __logf(l1 + (1.f - l1) * fsigmoid(v1[i])); }
                    } else if (seg == 3) {
#pragma unroll
                        for (int i = 0; i < 4; ++i) { v0[i] = v0[i] * fsigmoid(v0[i]); v1[i] = v1[i] * fsigmoid(v1[i]); }
                    }
                    u32x4 w; w.x = cvt_pk_bf16(v0[0], v0[1]); w.y = cvt_pk_bf16(v0[2], v0[3]); w.z = cvt_pk_bf16(v1[0], v1[1]); w.w = cvt_pk_bf16(v1[2], v1[3]);
                    *(u32x4*)(dst + 128 * bj) = w;
                }
            }
    }
};

struct EpiOutproj {
    static constexpr bool PERM = true, AFTER_DRAIN = false;
    const float* mod; bf16_t* DL;
    __device__ __forceinline__ void operator()(const f32x4 (&acc)[2][2][4][2], const Unit& u, int wr, int wc, int fr, int fq) const {
        const float* gt = mod + (u.pm >> 4) * 6144 + 2048;
        const int row0 = u.pm * BM + wr * 64 + fr, col0 = u.pn * BM + wc * 32 + 8 * fq;
        f32x4 gv[2][2];
#pragma unroll
        for (int bj = 0; bj < 2; ++bj)
#pragma unroll
            for (int n = 0; n < 2; ++n) gv[bj][n] = *(const f32x4*)(gt + col0 + bj * HALF + 4 * n);
#pragma unroll
        for (int ai = 0; ai < 2; ++ai)
#pragma unroll
            for (int m = 0; m < 4; ++m) { bf16_t* dst = DL + (size_t)(row0 + ai * HALF + m * 16) * 1024 + col0;
#pragma unroll
                for (int bj = 0; bj < 2; ++bj) { const f32x4 v0 = gv[bj][0] * acc[ai][bj][m][0], v1 = gv[bj][1] * acc[ai][bj][m][1];
                    u32x4 w; w.x = cvt_pk_bf16(v0[0], v0[1]); w.y = cvt_pk_bf16(v0[2], v0[3]); w.z = cvt_pk_bf16(v1[0], v1[1]); w.w = cvt_pk_bf16(v1[2], v1[3]);
                    *(u32x4*)(dst + bj * HALF) = w; } }
    }
};

template <bool GATHER_> struct GroupSchedT {
    static constexpr bool GATHER = GATHER_;
    const PG8_LAS int* tile_e; int nunits, G, c; size_t estride;
    const PG8_LAS int* rowtab;
    __device__ __forceinline__ int arow(int i, int r) const { return rowtab[i * 256 + r]; }
    __device__ __forceinline__ bool next(int i, Unit& u) const { const int L = i * G + c; if (L >= nunits) return false; u.pm = L >> 2; u.pn = L & 3; return true; }
    __device__ __forceinline__ const char* aptr(const Gemm& g, const Unit& u, size_t tstep) const { return GATHER ? (const char*)g.A : (const char*)g.A + (size_t)u.pm * tstep; }
    __device__ __forceinline__ const char* bptr(const Gemm& g, const Unit& u, size_t tstep) const { return (const char*)g.Bt + (size_t)tile_e[u.pm] * estride + (size_t)u.pn * tstep; }
    __device__ __forceinline__ void a_ready(const Unit&) const {}
    __device__ __forceinline__ void done(const Unit&) const {}
};
struct EpiMoe1 {
    static constexpr bool PERM = true, AFTER_DRAIN = false;
    bf16_t* ACT;
    __device__ __forceinline__ void operator()(const f32x4 (&acc)[2][2][4][2], const Unit& u, int wr, int wc, int fr, int fq) const {
        const int f0 = 128 * u.pn + 32 * wc + 8 * fq;
#pragma unroll
        for (int ai = 0; ai < 2; ++ai)
#pragma unroll
            for (int m = 0; m < 4; ++m) {
                const size_t slot = (size_t)u.pm * 256 + 128 * ai + 64 * wr + 16 * m + fr;
                f32x4 v0, v1;
#pragma unroll
                for (int i = 0; i < 4; ++i) { const float g0 = acc[ai][0][m][0][i], g1 = acc[ai][0][m][1][i]; v0[i] = g0 * fsigmoid(g0) * acc[ai][1][m][0][i]; v1[i] = g1 * fsigmoid(g1) * acc[ai][1][m][1][i]; }
                u32x4 w; w.x = cvt_pk_bf16(v0[0], v0[1]); w.y = cvt_pk_bf16(v0[2], v0[3]); w.z = cvt_pk_bf16(v1[0], v1[1]); w.w = cvt_pk_bf16(v1[2], v1[3]);
                *(u32x4*)(ACT + slot * 512 + f0) = w;
            }
    }
};
struct EpiMoe2 {
    static constexpr bool PERM = true, AFTER_DRAIN = false;
    bf16_t* YS; const PG8_LAS int* ridx; const PG8_LAS float* rw; int G, c;
    __device__ __forceinline__ void operator()(const f32x4 (&acc)[2][2][4][2], const Unit& u, int wr, int wc, int fr, int fq) const {
        const int uo = ((u.pm * 4 + u.pn) - c) / G;
        const int c0 = 256 * u.pn + 32 * wc + 8 * fq;
        int idxs[2][4]; float ws_[2][4];
#pragma unroll
        for (int ai = 0; ai < 2; ++ai)
#pragma unroll
            for (int m = 0; m < 4; ++m) { const int rl = 128 * ai + 64 * wr + 16 * m + fr; idxs[ai][m] = ridx[uo * 256 + rl]; ws_[ai][m] = rw[uo * 256 + rl]; }
#pragma unroll
        for (int ai = 0; ai < 2; ++ai)
#pragma unroll
            for (int m = 0; m < 4; ++m) {
                if (idxs[ai][m] >= 0) {
                    const int idx = idxs[ai][m]; const float w = ws_[ai][m];
                    unsigned char* dst = (unsigned char*)YS + (size_t)idx * 1024 + c0;
#pragma unroll
                    for (int bj = 0; bj < 2; ++bj) {
                        const f32x4 v0 = acc[ai][bj][m][0] * w, v1 = acc[ai][bj][m][1] * w;
                        u32x2 o; o.x = pack4_fp8(v0[0], v0[1], v0[2], v0[3]); o.y = pack4_fp8(v1[0], v1[1], v1[2], v1[3]);
                        *(u32x2*)(dst + 128 * bj) = o;
                    }
                }
            }
    }
};

struct EpiNull {
    static constexpr bool PERM = true, AFTER_DRAIN = false;
    __device__ __forceinline__ void operator()(const f32x4 (&acc)[2][2][4][2], const Unit&, int, int, int, int) const {
#pragma unroll
        for (int a = 0; a < 2; ++a)
#pragma unroll
            for (int b = 0; b < 2; ++b)
#pragma unroll
                for (int m = 0; m < 4; ++m)
#pragma unroll
                    for (int n = 0; n < 2; ++n) asm volatile("" :: "v"(acc[a][b][m][n]));
    }
};
template <class Epi, class Sched, bool ALIGN_EPI = false, bool SP2 = false>
__device__ __forceinline__ void gemm_phase(PG8_LAS unsigned char* lds, const Gemm g, const Sched& S, const Epi& E) {
    const int tid = threadIdx.x, wid = __builtin_amdgcn_readfirstlane(tid >> 6), lane = tid & 63, wr = wid >> 2, wc = wid & 3, fr = lane & 15, fq = lane >> 4;
    const int K = g.K, nt = K / BK, lda = g.lda ? g.lda : K, nsplit = g.nsplit; const long adelta = g.adelta;
    unsigned voffA[2], voffB[2];
#pragma unroll
    for (int i = 0; i < 2; ++i) { int R, C; stage_rc(tid * 16 + i * 8192, R, C); const int Rb = Epi::PERM ? ((R & ~31) + perm32(R & 31)) : R;
        voffA[i] = (unsigned)(R * lda + C) * 2u; voffB[i] = (unsigned)(Rb * K + C) * 2u; }
    constexpr bool GATHER = Sched::GATHER;
    static_assert(!GATHER || SP2, "gather staging is written for the SP2 loop");
    unsigned gA[2][2], gN[2][2], oN0[2], oN1[2]; int gR[2], gC[2];
    if constexpr (GATHER) {
#pragma unroll
        for (int i = 0; i < 2; ++i) { int R, C; stage_rc(tid * 16 + i * 8192, R, C); gR[i] = R; gC[i] = C * 2; }
#pragma unroll
        for (int h = 0; h < 2; ++h)
#pragma unroll
            for (int i = 0; i < 2; ++i) { gA[h][i] = (unsigned)S.arow(0, h * HALF + gR[i]) * (unsigned)(K * 2) + (unsigned)gC[i]; gN[h][i] = gA[h][i]; oN0[i] = gA[0][i]; oN1[i] = gA[1][i]; }
    }
#define PG8_STAGE_A(bufoff, ptr, half, nx) do { if constexpr (GATHER) { PG8_STAGE(bufoff, ptr, ((nx) ? ((half) ? oN1 : oN0) : gA[half])); } else { PG8_STAGE(bufoff, (ptr) + ((half) ? hstepA : (size_t)0), voffA); } } while (0)
    const size_t kstep = (size_t)(BK * 2);
    const size_t hstep = (size_t)HALF * K * 2;
    const size_t tstep = 2 * hstep;
    const size_t hstepA = (size_t)HALF * lda * 2, tstepA = 2 * hstepA;
#define PG8_AK(t_) ((size_t)(t_) * kstep + ((t_) >= nsplit ? (size_t)adelta : (size_t)0))
    const unsigned ldsw = (unsigned)wid * 1024u;
    const int aoff = lds_byte(wr * 64 + fr, fq * 8), boff = lds_byte(wc * 32 + fr, fq * 8);
#define PG8_SA(b, h) (((b) * 2 + (h)) * HTB)
#define PG8_SB(b, h) ((4 + (b) * 2 + (h)) * HTB)
#define PG8_STAGE(bufoff, gbase, voff) do { _Pragma("unroll") for (int _i = 0; _i < 2; ++_i) \
        __builtin_amdgcn_global_load_lds((const unsigned*)((const char*)(gbase) + (voff)[_i]), (PG8_LAS unsigned*)(lds + (bufoff) + ldsw + _i * 8192), 16, 0, 0); } while (0)
#define PG8_LDA(dst, b, h) do { _Pragma("unroll") for (int m = 0; m < 4; ++m) _Pragma("unroll") for (int k = 0; k < 2; ++k) dst[m][k] = *(const PG8_LAS bf16x8*)(lds + PG8_SA(b, h) + aoff + m * 2048 + k * 1024); } while (0)
#define PG8_LDB(dst, b, h) do { _Pragma("unroll") for (int n = 0; n < 2; ++n) _Pragma("unroll") for (int k = 0; k < 2; ++k) dst[n][k] = *(const PG8_LAS bf16x8*)(lds + PG8_SB(b, h) + boff + n * 2048 + k * 1024); } while (0)
#define PG8_MMA(ai, bj, At, Bt) do { __builtin_amdgcn_s_setprio(1); _Pragma("unroll") for (int m = 0; m < 4; ++m) _Pragma("unroll") for (int n = 0; n < 2; ++n) _Pragma("unroll") for (int k = 0; k < 2; ++k) \
        acc[ai][bj][m][n] = __builtin_amdgcn_mfma_f32_16x16x32_bf16(Bt[n][k], At[m][k], acc[ai][bj][m][n], 0, 0, 0); __builtin_amdgcn_s_setprio(0); } while (0)
#define PG8_WAIT_V(n) asm volatile("s_waitcnt vmcnt(" #n ")" ::: "memory")
#define PG8_WAIT_L(n) asm volatile("s_waitcnt lgkmcnt(" #n ")" ::: "memory")
#define PG8_BAR __builtin_amdgcn_s_barrier()
#define PG8_SCHED __builtin_amdgcn_sched_barrier(0)
    Unit cur, nxt; int ui = 0;
    if (!S.next(0, cur)) return;
    f32x4 acc[2][2][4][2];
#pragma unroll
    for (int a = 0; a < 2; ++a)
#pragma unroll
        for (int b = 0; b < 2; ++b)
#pragma unroll
            for (int m = 0; m < 4; ++m)
#pragma unroll
                for (int n = 0; n < 2; ++n) acc[a][b][m][n] = (f32x4){0.f, 0.f, 0.f, 0.f};
    bf16x8 At[4][2], B0[2][2], B1[2][2];
    const char* cA = S.aptr(g, cur, tstepA); const char* cB = S.bptr(g, cur, tstep);
    S.a_ready(cur);
    if constexpr (SP2) {
        PG8_STAGE(PG8_SB(0, 0), cB, voffB); PG8_STAGE(PG8_SB(0, 1), cB + hstep, voffB); PG8_STAGE_A(PG8_SA(0, 0), cA, 0, 0); PG8_STAGE_A(PG8_SA(0, 1), cA, 1, 0);
        if (wr == 1) PG8_BAR;
        PG8_WAIT_V(2); PG8_BAR;
        PG8_STAGE(PG8_SB(1, 0), cB + kstep, voffB); PG8_STAGE_A(PG8_SA(1, 0), cA + PG8_AK(1), 0, 0); PG8_STAGE(PG8_SB(1, 1), cB + hstep + kstep, voffB);
        PG8_WAIT_V(6); PG8_BAR;
    } else {
        PG8_STAGE(PG8_SB(0, 0), cB, voffB); PG8_STAGE(PG8_SA(0, 0), cA, voffA); PG8_STAGE(PG8_SB(0, 1), cB + hstep, voffB); PG8_STAGE(PG8_SA(0, 1), cA + hstep, voffA);
        if (wr == 1) PG8_BAR;
        PG8_WAIT_V(4); PG8_BAR;
        PG8_STAGE(PG8_SB(1, 0), cB + kstep, voffB); PG8_STAGE(PG8_SA(1, 0), cA + kstep, voffA); PG8_STAGE(PG8_SB(1, 1), cB + hstep + kstep, voffB);
        PG8_WAIT_V(6); PG8_BAR;
    }
    for (;;) {
        const bool has_next = S.next(ui + 1, nxt);
        const char* nA = has_next ? S.aptr(g, nxt, tstepA) : cA; const char* nB = has_next ? S.bptr(g, nxt, tstep) : cB;
        if constexpr (GATHER) {
#pragma unroll
            for (int h = 0; h < 2; ++h)
#pragma unroll
                for (int i = 0; i < 2; ++i) gN[h][i] = has_next ? (unsigned)S.arow(ui + 1, h * HALF + gR[i]) * (unsigned)(K * 2) + (unsigned)gC[i] : gA[h][i];
        }
        for (int t = 0; t < nt; t += 2) {
            const bool last = (t == nt - 2);
            const char* a1 = cA + PG8_AK(t + 1);
            const char* a2 = last ? nA : cA + PG8_AK(t + 2); const char* b2 = last ? nB : cB + (size_t)(t + 2) * kstep;
            const char* a3 = last ? nA + PG8_AK(1) : cA + PG8_AK(t + 3); const char* b3 = b2 + kstep;
            if (last && has_next) S.a_ready(nxt);
            if constexpr (GATHER) {
#pragma unroll
                for (int i = 0; i < 2; ++i) { oN0[i] = last ? gN[0][i] : gA[0][i]; oN1[i] = last ? gN[1][i] : gA[1][i]; }
            }
            if constexpr (SP2) {
            PG8_LDB(B0, 0, 0); PG8_LDB(B1, 0, 1); PG8_SCHED; PG8_LDA(At, 0, 0); PG8_STAGE_A(PG8_SA(1, 1), a1, 1, 0);
            PG8_WAIT_V(8); PG8_WAIT_L(0); PG8_BAR; PG8_MMA(0, 0, At, B0); PG8_MMA(0, 1, At, B1); PG8_BAR; PG8_SCHED;
            PG8_LDA(At, 0, 1); PG8_STAGE(PG8_SB(0, 0), b2, voffB); PG8_STAGE(PG8_SB(0, 1), b2 + hstep, voffB); PG8_STAGE_A(PG8_SA(0, 0), a2, 0, 1);
            PG8_WAIT_V(8); PG8_WAIT_L(0); PG8_BAR; PG8_MMA(1, 0, At, B0); PG8_MMA(1, 1, At, B1); PG8_BAR; PG8_SCHED;
            PG8_LDB(B0, 1, 0); PG8_LDB(B1, 1, 1); PG8_SCHED; PG8_LDA(At, 1, 0); PG8_STAGE_A(PG8_SA(0, 1), a2, 1, 1);
            PG8_WAIT_V(8); PG8_WAIT_L(0); PG8_BAR; PG8_MMA(0, 0, At, B0); PG8_MMA(0, 1, At, B1); PG8_BAR; PG8_SCHED;
            PG8_LDA(At, 1, 1); PG8_STAGE(PG8_SB(1, 0), b3, voffB); PG8_STAGE(PG8_SB(1, 1), b3 + hstep, voffB); PG8_STAGE_A(PG8_SA(1, 0), a3, 0, 1);
            PG8_WAIT_V(8); PG8_WAIT_L(0); PG8_BAR; PG8_MMA(1, 0, At, B0); PG8_MMA(1, 1, At, B1); PG8_BAR; PG8_SCHED;
            } else {
            PG8_LDB(B0, 0, 0); PG8_SCHED; PG8_LDA(At, 0, 0); PG8_STAGE(PG8_SA(1, 1), a1 + hstep, voffA);
            PG8_WAIT_L(8); PG8_BAR; PG8_WAIT_L(0); PG8_MMA(0, 0, At, B0); PG8_BAR; PG8_SCHED;
            PG8_LDB(B1, 0, 1); PG8_STAGE(PG8_SB(0, 0), b2, voffB);
            PG8_BAR; PG8_WAIT_L(0); PG8_MMA(0, 1, At, B1); PG8_BAR;
            PG8_LDA(At, 0, 1); PG8_STAGE(PG8_SA(0, 0), a2, voffA);
            PG8_BAR; PG8_WAIT_L(0); PG8_MMA(1, 0, At, B0); PG8_BAR; PG8_SCHED;
            PG8_STAGE(PG8_SB(0, 1), b2 + hstep, voffB);
            PG8_WAIT_V(6); PG8_BAR; PG8_MMA(1, 1, At, B1); PG8_BAR;
            PG8_LDB(B0, 1, 0); PG8_SCHED; PG8_LDA(At, 1, 0); PG8_STAGE(PG8_SA(0, 1), a2 + hstep, voffA);
            PG8_WAIT_L(8); PG8_BAR; PG8_WAIT_L(0); PG8_MMA(0, 0, At, B0); PG8_BAR; PG8_SCHED;
            PG8_LDB(B1, 1, 1); PG8_STAGE(PG8_SB(1, 0), b3, voffB);
            PG8_BAR; PG8_WAIT_L(0); PG8_MMA(0, 1, At, B1); PG8_BAR;
            PG8_LDA(At, 1, 1); PG8_STAGE(PG8_SA(1, 0), a3, voffA);
            PG8_BAR; PG8_WAIT_L(0); PG8_MMA(1, 0, At, B0); PG8_BAR; PG8_SCHED;
            PG8_STAGE(PG8_SB(1, 1), b3 + hstep, voffB);
            PG8_WAIT_V(6); PG8_BAR; PG8_MMA(1, 1, At, B1); PG8_BAR;
            }
        }
        if constexpr (ALIGN_EPI) { if (wr == 0) PG8_BAR; }
        if constexpr (!Epi::AFTER_DRAIN) { E(acc, cur, wr, wc, fr, fq); S.done(cur); }
        if (!has_next) break;
#pragma unroll
        for (int a = 0; a < 2; ++a)
#pragma unroll
            for (int b = 0; b < 2; ++b)
#pragma unroll
                for (int m = 0; m < 4; ++m)
#pragma unroll
                    for (int n = 0; n < 2; ++n) acc[a][b][m][n] = (f32x4){0.f, 0.f, 0.f, 0.f};
        cur = nxt; cA = nA; cB = nB; ++ui;
        if constexpr (GATHER) {
#pragma unroll
            for (int h = 0; h < 2; ++h)
#pragma unroll
                for (int i = 0; i < 2; ++i) gA[h][i] = gN[h][i];
        }
        if constexpr (ALIGN_EPI) { if (wr == 1) PG8_BAR; }
    }
    PG8_WAIT_V(0);
    if constexpr (!ALIGN_EPI) { if (wr == 0) PG8_BAR; }
    PG8_BAR;
    if constexpr (Epi::AFTER_DRAIN) { E.fused(acc, cur, wr, wc, fr, fq, lds, wid, lane); S.done(cur); }
#undef PG8_SA
#undef PG8_SB
#undef PG8_STAGE
#undef PG8_STAGE_A
#undef PG8_AK
#undef PG8_LDA
#undef PG8_LDB
#undef PG8_MMA
#undef PG8_WAIT_V
#undef PG8_WAIT_L
#undef PG8_BAR
#undef PG8_SCHED
}
}
#include <hip/hip_bf16.h>
#include <cmath>
namespace attn_body {
using bf16=__hip_bfloat16;
using bf16x8=__attribute__((ext_vector_type(8)))short;
using s16x4=__attribute__((ext_vector_type(4)))short;
using f32x16=__attribute__((ext_vector_type(16)))float;
using u32x4=__attribute__((ext_vector_type(4)))unsigned;
using f32x4=__attribute__((ext_vector_type(4)))float;
constexpr int D=64,QP=512,KVP=128,OP=512,SEQQ=4096,SEQK=4352;
constexpr int NW=8,QBLK=32,QB=QBLK*NW,KVBLK=64,NQB=SEQQ/QB;
constexpr int ATTN_UNIT_ROWS=QB;
__device__ __forceinline__ int crow(int r,int hi){return (r&3)+8*(r>>2)+4*hi;}
#define SBAR() __builtin_amdgcn_sched_barrier(0)
__device__ __forceinline__ void cmask(f32x16&p0,f32x16&p1,int jb,int qrel,int hi){
  const float NEG=-INFINITY; int kb=64*jb+4*hi;
  #pragma unroll
  for(int r=0;r<16;++r){int kv=kb+(r&3)+8*(r>>2); if(kv>qrel)p0[r]=NEG; if(kv+32>qrel)p1[r]=NEG;}
}

constexpr int NSLOT=3, SLOTB=8192;
constexpr int LDS_K=0, LDS_V=NSLOT*SLOTB, LDS_WS=2*NSLOT*SLOTB, LDS_OST=LDS_WS+NW*64*4, LDS_BYTES=LDS_OST+NW*4096;
constexpr float C2=0.125f*1.4426950408889634f;
__device__ __forceinline__ void glds16(const void*gsrc,unsigned lds_dst){unsigned keep;
  asm volatile("s_mov_b32 %0, m0\n\ts_mov_b32 m0, %2\n\ts_nop 0\n\tglobal_load_lds_dwordx4 %1, off\n\ts_mov_b32 m0, %0":"=&s"(keep):"v"(gsrc),"s"(lds_dst):"memory");}
__device__ __forceinline__ float max3f(float a,float b,float c){float r;asm("v_max3_f32 %0, %1, %2, %3":"=v"(r):"v"(a),"v"(b),"v"(c));return r;}
__device__ __forceinline__ float max2f(float a,float b){float r;asm("v_max_f32_e32 %0, %1, %2":"=v"(r):"v"(a),"v"(b));return r;}
__device__ __forceinline__ float fadd_s(float a,float b){float r;asm("v_add_f32_e32 %0, %1, %2":"=v"(r):"v"(a),"v"(b));return r;}
__device__ __forceinline__ float fsub_s(float a,float b){float r;asm("v_sub_f32_e32 %0, %1, %2":"=v"(r):"v"(a),"v"(b));return r;}
typedef float f32x2_t __attribute__((ext_vector_type(2))); typedef __bf16 bf16x2_t __attribute__((ext_vector_type(2)));
__device__ __forceinline__ unsigned cvtpk_s(float lo,float hi){f32x2_t v={lo,hi};bf16x2_t b=__builtin_convertvector(v,bf16x2_t);return __builtin_bit_cast(unsigned,b);}
#define WAIT_BAR(N) asm volatile("s_waitcnt vmcnt(" #N ") lgkmcnt(0)\n\ts_barrier":::"memory")

__device__ __forceinline__ void qkt(f32x16&p0,f32x16&p1,const char*Kslot,const bf16x8*qr,const f32x16&negm,int r32,int hi){
  const char*kb=Kslot+hi*1024+r32*16;
  #pragma unroll
  for(int d0=0;d0<4;++d0){
    const bf16x8 b0=*reinterpret_cast<const bf16x8*>(kb+d0*2048);
    const bf16x8 b1=*reinterpret_cast<const bf16x8*>(kb+d0*2048+512);
    if(d0==0){p0=__builtin_amdgcn_mfma_f32_32x32x16_bf16(b0,qr[0],negm,0,0,0);p1=__builtin_amdgcn_mfma_f32_32x32x16_bf16(b1,qr[0],negm,0,0,0);}
    else{p0=__builtin_amdgcn_mfma_f32_32x32x16_bf16(b0,qr[d0],p0,0,0,0);p1=__builtin_amdgcn_mfma_f32_32x32x16_bf16(b1,qr[d0],p1,0,0,0);}}
}
typedef __attribute__((address_space(3))) const char* lds_cptr;
typedef short v4i16_t __attribute__((ext_vector_type(4)));
__device__ __forceinline__ void kload8(bf16x8*kf,lds_cptr kp){
  kf[0]=*(const __attribute__((address_space(3))) bf16x8*)(kp);      kf[1]=*(const __attribute__((address_space(3))) bf16x8*)(kp+512);
  kf[2]=*(const __attribute__((address_space(3))) bf16x8*)(kp+2048); kf[3]=*(const __attribute__((address_space(3))) bf16x8*)(kp+2560);
  kf[4]=*(const __attribute__((address_space(3))) bf16x8*)(kp+4096); kf[5]=*(const __attribute__((address_space(3))) bf16x8*)(kp+4608);
  kf[6]=*(const __attribute__((address_space(3))) bf16x8*)(kp+6144); kf[7]=*(const __attribute__((address_space(3))) bf16x8*)(kp+6656);
}
__device__ __forceinline__ void kload2(bf16x8*kf,lds_cptr kp,int j){ kf[2*j]=*(const __attribute__((address_space(3))) bf16x8*)(kp+j*2048); kf[2*j+1]=*(const __attribute__((address_space(3))) bf16x8*)(kp+j*2048+512); }
__device__ __forceinline__ s16x4 vtr(lds_cptr p){ return __builtin_bit_cast(s16x4,__builtin_amdgcn_ds_read_tr16_b64_v4i16((__attribute__((address_space(3))) v4i16_t*)p)); }
__device__ __forceinline__ float rowmax(const f32x16&p0,const f32x16&p1){
  float a=max3f(p0[0],p0[1],p1[0]),b=max3f(p0[2],p0[3],p1[1]);a=max3f(a,p1[2],p1[3]);
  #pragma unroll
  for(int r=4;r<16;r+=4){a=max3f(a,p0[r],p0[r+1]);b=max3f(b,p0[r+2],p0[r+3]);a=max3f(a,p1[r],p1[r+1]);b=max3f(b,p1[r+2],p1[r+3]);}
  const float m=max2f(a,b);
  auto rr=__builtin_amdgcn_permlane32_swap(__float_as_uint(m),__float_as_uint(m),false,false);
  return max2f(__uint_as_float(rr[0]),__uint_as_float(rr[1]));
}
__device__ __forceinline__ void pv(f32x16*o,int vb,bf16x8 pa0,bf16x8 pa1,bf16x8 pa2,bf16x8 pa3){
  #pragma unroll
  for(int d0=0;d0<2;++d0){s16x4 lo[4],hi[4];
    #pragma unroll
    for(int ks=0;ks<4;++ks){
      asm volatile("ds_read_b64_tr_b16 %0,%1 offset:%c2":"=&v"(lo[ks]):"v"(vb),"i"(d0*4096+ks*1024):"memory");
      asm volatile("ds_read_b64_tr_b16 %0,%1 offset:%c2":"=&v"(hi[ks]):"v"(vb),"i"(d0*4096+ks*1024+512):"memory");}
    asm volatile("s_waitcnt lgkmcnt(0)":::"memory");SBAR();
    #define PK(k) (bf16x8){lo[k][0],lo[k][1],lo[k][2],lo[k][3],hi[k][0],hi[k][1],hi[k][2],hi[k][3]}
    o[d0]=__builtin_amdgcn_mfma_f32_32x32x16_bf16(pa0,PK(0),o[d0],0,0,0);
    o[d0]=__builtin_amdgcn_mfma_f32_32x32x16_bf16(pa1,PK(1),o[d0],0,0,0);
    o[d0]=__builtin_amdgcn_mfma_f32_32x32x16_bf16(pa2,PK(2),o[d0],0,0,0);
    o[d0]=__builtin_amdgcn_mfma_f32_32x32x16_bf16(pa3,PK(3),o[d0],0,0,0);
    #undef PK
  }
}

#ifndef ATTN_STORE16
#define ATTN_STORE16(p,v) (*(u32x4*)(p)=(v))
#endif
template<int THRL> __device__ __forceinline__ void attn_unit(int b,int h,int qb,const bf16*Q,const bf16*__restrict__ K,const bf16*__restrict__ V,bf16*O,const float*__restrict__ og,char*shm){
  const int kvh=h>>2;
  const int tid=threadIdx.x,lane=tid&63,r32=lane&31,hi=lane>>5; const int wid=__builtin_amdgcn_readfirstlane(tid>>6);
  const long rowbase=(long)b*SEQQ, rowbasek=(long)b*SEQK; const int q0=qb*QB;
  const bf16*Qw=Q+(rowbase+q0+wid*QBLK)*QP+h*D;
  const bf16*Kh=K+rowbasek*KVP+kvh*D,*Vh=V+rowbasek*KVP+kvh*D;
  const unsigned lds0=(unsigned)(uintptr_t)shm;
  float*wsf=(float*)(shm+LDS_WS)+wid*64;
  const bf16*ksrc=Kh+(long)lane*KVP+wid*8;
  const bf16*vsrc=Vh+(long)(16*(wid&3)+(lane>>2))*KVP+(wid>>2)*32+(lane&3)*8;
  const unsigned kdst=lds0+LDS_K+wid*1024, vdst=lds0+LDS_V+wid*1024;
  #define DMA_K(t,slot) glds16(ksrc+(long)(t)*KVBLK*KVP,(unsigned)__builtin_amdgcn_readfirstlane(kdst+(slot)))
  #define DMA_V(t,slot) glds16(vsrc+(long)(t)*KVBLK*KVP,(unsigned)__builtin_amdgcn_readfirstlane(vdst+(slot)))
  const int vb0=(int)(lds0+LDS_V)+((lane>>4)&1)*32+(lane&3)*8+(4*hi+((lane&15)>>2))*64;
  const char*Kbase=shm+LDS_K; bf16x8 kf[8];
  const lds_cptr shm3=(lds_cptr)shm; const lds_cptr kp0=shm3+LDS_K+hi*1024+r32*16; const lds_cptr vp0=shm3+LDS_V+((lane>>4)&1)*32+(lane&3)*8+(4*hi+((lane&15)>>2))*64;
  constexpr int NT=SEQK/KVBLK;
  DMA_K(0,0);DMA_V(0,0);DMA_K(1,SLOTB);
  bf16x8 qr[4];
  #pragma unroll
  for(int d0=0;d0<4;++d0)qr[d0]=*reinterpret_cast<const bf16x8*>(&Qw[(long)r32*QP+d0*16+hi*8]);
  float mhat=0.f,l_reg=0.f;f32x16 o[2];o[0]=f32x16{};o[1]=f32x16{};f32x16 negm=f32x16{};asm volatile("":"+v"(negm));
  #define CMASK(P0,P1,t) do{}while(0)
  bool resc=false;
  #define START(P0,P1) do{ const float rm=rowmax(P0,P1); resc=false; \
    { const float dl=rm; mhat=fadd_s(mhat,dl); \
      _Pragma("unroll") for(int r=0;r<16;++r){P0[r]=fsub_s(P0[r],dl);P1[r]=fsub_s(P1[r],dl);} \
      _Pragma("unroll") for(int r=0;r<16;++r)negm[r]=-mhat; asm volatile("":"+v"(negm)); } \
    _Pragma("unroll") for(int r=0;r<16;++r)P0[r]=__builtin_amdgcn_exp2f(P0[r]); }while(0)
  #define RESC() do{ if(resc){ asm volatile("s_waitcnt lgkmcnt(0)":::"memory"); \
      _Pragma("unroll") for(int d_=0;d_<2;++d_) _Pragma("unroll") for(int r=0;r<16;++r)o[d_][r]*=wsf[crow(r,hi)]; } }while(0)
  f32x16 pA0,pA1,pB0,pB1;
  int sl_prev=0,sl_cur=0,sl_next=SLOTB;
  #define ROT() do{sl_prev=sl_cur;sl_cur=sl_next;sl_next=(sl_next==(NSLOT-1)*SLOTB)?0:sl_next+SLOTB;}while(0)
  DMA_K(2,2*SLOTB);
  WAIT_BAR(3);
  qkt(pA0,pA1,Kbase,qr,negm,r32,hi);asm volatile("s_nop 15\n\ts_nop 7":"+v"(pA0),"+v"(pA1));CMASK(pA0,pA1,0);
  START(pA0,pA1);
  _Pragma("unroll") for(int r=0;r<16;++r)pA1[r]=__builtin_amdgcn_exp2f(pA1[r]);
  WAIT_BAR(0);
  DMA_K(3,0);DMA_V(1,SLOTB);
  ROT();
  kload8(kf,kp0+sl_cur);
  WAIT_BAR(2);
  s16x4 vlo[8],vhi[8]; u32x4 pw0,pw1,pw2,pw3;
  #define PKW(P,B) cvtpk_s(P[B],P[B+1])
  #define PAF(k) __builtin_bit_cast(bf16x8,pw##k)
  #define VFR(i) (bf16x8){vlo[i][0],vlo[i][1],vlo[i][2],vlo[i][3],vhi[i][0],vhi[i][1],vhi[i][2],vhi[i][3]}
  #define PIN(x) asm volatile("":"+v"(x))
  #define MX3(a,b,c) __builtin_fmaxf(__builtin_fmaxf((a),(b)),(c))
  #define GAPA(MF,A0,A1,A2,A3,W0,W1,PW) do{ MF; sacc+=A0; sacc+=A1; sacc+=A2; sacc+=A3; PIN(sacc); W0; W1; PIN(PW); SBAR(); }while(0)
  #define EX(v) __builtin_amdgcn_exp2f(v)
  #define GAPB(MF,X,B) do{ MF; X[B]=EX(X[B]); X[B+1]=EX(X[B+1]); X[B+2]=EX(X[B+2]); X[B+3]=EX(X[B+3]); PIN(X); SBAR(); }while(0)
  #define VRD(i) do{ vlo[i]=vtr(vp_+(((i)>>2)*4096+((i)&3)*1024)); vhi[i]=vtr(vp_+(((i)>>2)*4096+((i)&3)*1024+512)); }while(0)
  #define KRD(G,j) do{ if(G){ kload2(kf,kp0+sl_next,j); SBAR(); } }while(0)
  #define STEP(C0,C1,P0,P1,t,GK,GV,GL) do{ SBAR(); \
    const lds_cptr vp_=vp0+sl_prev; \
    VRD(0); SBAR(); float sacc=(P0[0]+P0[1]); \
    GAPA(C0=__builtin_amdgcn_mfma_f32_32x32x16_bf16(kf[0],qr[0],negm,0,0,0), P0[2],P0[3],P0[4],P0[5],     pw0[0]=PKW(P0,0), pw0[1]=PKW(P0,2), pw0); \
    VRD(4); SBAR(); GAPA(C1=__builtin_amdgcn_mfma_f32_32x32x16_bf16(kf[1],qr[0],negm,0,0,0), P0[6],P0[7],P0[8],P0[9],     pw0[2]=PKW(P0,4), pw0[3]=PKW(P0,6), pw0); \
    VRD(1); SBAR(); GAPA(C0=__builtin_amdgcn_mfma_f32_32x32x16_bf16(kf[2],qr[1],C0,0,0,0),   P0[10],P0[11],P0[12],P0[13], pw1[0]=PKW(P0,8), pw1[1]=PKW(P0,10), pw1); \
    VRD(5); SBAR(); GAPA(C1=__builtin_amdgcn_mfma_f32_32x32x16_bf16(kf[3],qr[1],C1,0,0,0),   P0[14],P0[15],P1[0],P1[1],   pw1[2]=PKW(P0,12),pw1[3]=PKW(P0,14), pw1); \
    VRD(2); SBAR(); GAPA(C0=__builtin_amdgcn_mfma_f32_32x32x16_bf16(kf[4],qr[2],C0,0,0,0),   P1[2],P1[3],P1[4],P1[5],     pw2[0]=PKW(P1,0), pw2[1]=PKW(P1,2), pw2); \
    VRD(6); SBAR(); GAPA(C1=__builtin_amdgcn_mfma_f32_32x32x16_bf16(kf[5],qr[2],C1,0,0,0),   P1[6],P1[7],P1[8],P1[9],     pw2[2]=PKW(P1,4), pw2[3]=PKW(P1,6), pw2); \
    VRD(3); SBAR(); GAPA(C0=__builtin_amdgcn_mfma_f32_32x32x16_bf16(kf[6],qr[3],C0,0,0,0),   P1[10],P1[11],P1[12],P1[13], pw3[0]=PKW(P1,8), pw3[1]=PKW(P1,10), pw3); \
    VRD(7); SBAR(); GAPA(C1=__builtin_amdgcn_mfma_f32_32x32x16_bf16(kf[7],qr[3],C1,0,0,0),   P1[14],P1[15],0.f,0.f,       pw3[2]=PKW(P1,12),pw3[3]=PKW(P1,14), pw3); \
    l_reg+=sacc; \
    if(GK){DMA_K((t)+3,sl_cur);} if(GV){DMA_V((t)+1,sl_next);} \
    CMASK(C0,C1,t); \
    { float a=MX3(C0[0],C0[1],C1[0]),b=MX3(C0[2],C0[3],C1[1]); a=MX3(a,C1[2],C1[3]); \
      _Pragma("unroll") for(int r=4;r<16;r+=4){a=MX3(a,C0[r],C0[r+1]);b=MX3(b,C0[r+2],C0[r+3]);a=MX3(a,C1[r],C1[r+1]);b=MX3(b,C1[r+2],C1[r+3]);} \
      float rm=__builtin_fmaxf(a,b); { auto rr=__builtin_amdgcn_permlane32_swap(__float_as_uint(rm),__float_as_uint(rm),false,false); rm=__builtin_fmaxf(__uint_as_float(rr[0]),__uint_as_float(rr[1])); } \
      resc=false; \
      if(__builtin_expect(__any(rm>(float)THRL),0)){ const float dl=__builtin_fmaxf(rm,0.f); mhat+=dl; \
        _Pragma("unroll") for(int r=0;r<16;++r){C0[r]-=dl;C1[r]-=dl;} \
        _Pragma("unroll") for(int r=0;r<16;++r)negm[r]=-mhat; asm volatile("":"+v"(negm)); \
        const float f=__builtin_amdgcn_exp2f(-dl); l_reg*=f; if(hi==0)wsf[r32]=f; resc=true; } } \
    SBAR(); \
    GAPB(o[0]=__builtin_amdgcn_mfma_f32_32x32x16_bf16(PAF(0),VFR(0),o[0],0,0,0), C0,0); \
    GAPB(o[1]=__builtin_amdgcn_mfma_f32_32x32x16_bf16(PAF(0),VFR(4),o[1],0,0,0), C0,4); \
    KRD(GL,0); GAPB(o[0]=__builtin_amdgcn_mfma_f32_32x32x16_bf16(PAF(1),VFR(1),o[0],0,0,0), C0,8); \
    KRD(GL,1); GAPB(o[1]=__builtin_amdgcn_mfma_f32_32x32x16_bf16(PAF(1),VFR(5),o[1],0,0,0), C0,12); \
    KRD(GL,2); GAPB(o[0]=__builtin_amdgcn_mfma_f32_32x32x16_bf16(PAF(2),VFR(2),o[0],0,0,0), C1,0); \
    KRD(GL,3); GAPB(o[1]=__builtin_amdgcn_mfma_f32_32x32x16_bf16(PAF(2),VFR(6),o[1],0,0,0), C1,4); \
    GAPB(o[0]=__builtin_amdgcn_mfma_f32_32x32x16_bf16(PAF(3),VFR(3),o[0],0,0,0), C1,8); \
    GAPB(o[1]=__builtin_amdgcn_mfma_f32_32x32x16_bf16(PAF(3),VFR(7),o[1],0,0,0), C1,12); \
    }while(0)
  int t=1;
  #undef CMASK
  #define CMASK(P0,P1,t) do{}while(0)
  for(;t+5<NT;t+=2){
    STEP(pB0,pB1,pA0,pA1,t,true,true,true);     WAIT_BAR(2); RESC(); ROT();
    STEP(pA0,pA1,pB0,pB1,t+1,true,true,true);   WAIT_BAR(2); RESC(); ROT();
  }
  #undef CMASK
  #define CMASK(P0,P1,t) do{}while(0)
  #define ENDW(tt) do{ if((tt)+3<NT){WAIT_BAR(2);} else if((tt)+2<NT){WAIT_BAR(1);} else {WAIT_BAR(0);} }while(0)
  for(;t+1<NT;t+=2){
    STEP(pB0,pB1,pA0,pA1,t,(t+3<NT),(t+1<NT),(t+1<NT));       ENDW(t);   RESC(); ROT();
    STEP(pA0,pA1,pB0,pB1,t+1,(t+4<NT),(t+2<NT),(t+2<NT));     ENDW(t+1); RESC(); ROT();
  }
  STEP(pB0,pB1,pA0,pA1,NT-1,false,false,false); RESC();
  { float sacc=pB0[0]+pB0[1]; _Pragma("unroll") for(int r=2;r<16;++r)sacc+=pB0[r]; _Pragma("unroll") for(int r=0;r<16;++r)sacc+=pB1[r]; l_reg+=sacc;
    pw0=(u32x4){PKW(pB0,0),PKW(pB0,2),PKW(pB0,4),PKW(pB0,6)};pw1=(u32x4){PKW(pB0,8),PKW(pB0,10),PKW(pB0,12),PKW(pB0,14)};pw2=(u32x4){PKW(pB1,0),PKW(pB1,2),PKW(pB1,4),PKW(pB1,6)};pw3=(u32x4){PKW(pB1,8),PKW(pB1,10),PKW(pB1,12),PKW(pB1,14)};
    SBAR(); pv(o,vb0+sl_cur,PAF(0),PAF(1),PAF(2),PAF(3)); }
  #undef PKW
  #undef PAF
  #undef VFR
  #undef PIN
  #undef MX3
  #undef GAPA
  #undef GAPB
  #undef EX
  #undef VRD
  #undef KRD
  #undef STEP
  #undef ENDW
  {auto rr=__builtin_amdgcn_permlane32_swap(__float_as_uint(l_reg),__float_as_uint(l_reg),false,false);l_reg=__uint_as_float(rr[0])+__uint_as_float(rr[1]);}
  if(hi==0)wsf[32+r32]=l_reg;asm volatile("s_waitcnt lgkmcnt(0)":::"memory");
  float rli[16];
  #pragma unroll
  for(int r=0;r<16;++r)rli[r]=__builtin_amdgcn_rcpf(wsf[32+crow(r,hi)]);
  bf16*Ow=O+(rowbase+q0+wid*QBLK)*OP+h*D;
  { bf16*stg=(bf16*)(shm+LDS_OST)+wid*2048;
    #pragma unroll
    for(int r=0;r<16;++r){const int orow=crow(r,hi);
      #pragma unroll
      for(int d0=0;d0<2;++d0)stg[orow*64+d0*32+r32]=__float2bfloat16(o[d0][r]*rli[r]);}
    asm volatile("s_waitcnt lgkmcnt(0)":::"memory");
    const f32x4 og0=*(const f32x4*)(og+h*64+(lane&7)*8), og1=*(const f32x4*)(og+h*64+(lane&7)*8+4);
    #pragma unroll
    for(int i=0;i<4;++i){const int row=i*8+(lane>>3),ch=lane&7; const u32x4 v=*(const u32x4*)(stg+row*64+ch*8);
      const unsigned w[4]={v.x,v.y,v.z,v.w}; float x[8]; float ss=0.f;
      #pragma unroll
      for(int p=0;p<4;++p){x[2*p]=__uint_as_float(w[p]<<16);x[2*p+1]=__uint_as_float(w[p]&0xffff0000u);ss+=x[2*p]*x[2*p]+x[2*p+1]*x[2*p+1];}
      ss+=__shfl_xor(ss,1);ss+=__shfl_xor(ss,2);ss+=__shfl_xor(ss,4);
      const float rs=rsqrtf(ss*(1.f/64.f)+1e-6f);
      u32x4 o4; o4.x=cvtpk_s(x[0]*rs*og0[0],x[1]*rs*og0[1]); o4.y=cvtpk_s(x[2]*rs*og0[2],x[3]*rs*og0[3]); o4.z=cvtpk_s(x[4]*rs*og1[0],x[5]*rs*og1[1]); o4.w=cvtpk_s(x[6]*rs*og1[2],x[7]*rs*og1[3]);
      ATTN_STORE16(Ow+(long)row*OP+ch*8,o4);} }
  asm volatile("s_waitcnt lgkmcnt(0)\n\ts_barrier":::"memory");
  #undef DMA_K
  #undef DMA_V
  #undef CMASK
  #undef START
  #undef RESC
  #undef ROT
}
constexpr int ATTN_LDS_BYTES=LDS_BYTES;
struct AttnTensors { const bf16* Q; const bf16* K; const bf16* V; bf16* O; const float* og; };
struct AttnUnit { int bh; int qb; };
struct StaticOrder {
  int vcu;
  __device__ __forceinline__ explicit StaticOrder(int grid,int block):vcu((block%8)*(grid/8)+block/8){}
  __device__ __forceinline__ bool next(int i,AttnUnit&u)const{ if(i>=4)return false; const int w=32*i+(vcu&31); u.bh=(vcu>>5)*8+(w>>4); u.qb=w&15; return true; }
  __device__ __forceinline__ void a_ready(const AttnUnit&)const{}
  __device__ __forceinline__ void done(const AttnUnit&)const{}
};
template<class Sched,int THRL=8> __device__ __forceinline__ void attn_phase(char*lds,const AttnTensors&T,const Sched&S){
  AttnUnit u;
  for(int i=0;S.next(i,u);++i){ S.a_ready(u); attn_unit<THRL>(u.bh>>3,u.bh&7,u.qb,T.Q,T.K,T.V,T.O,T.og,lds); S.done(u); }
}
#undef SBAR
#undef WAIT_BAR
}
constexpr int NWAVES = 8;
constexpr int RING_OFF = 0, RING_BYTES = 131072;
constexpr int ROPE_OFF = RING_BYTES;
constexpr int MISC_OFF = ROPE_OFF + 8192;
constexpr int XTRA_OFF = 147456;
constexpr int LDS_BYTES = 163840;
#define LAS __attribute__((address_space(3)))
typedef unsigned v4u __attribute__((ext_vector_type(4)));
typedef unsigned v2u __attribute__((ext_vector_type(2)));
typedef float f32x4 __attribute__((ext_vector_type(4)));
#define LDS_WAIT() asm volatile("s_waitcnt lgkmcnt(0)" ::: "memory")
#define LBAR() do { asm volatile("s_waitcnt lgkmcnt(0)" ::: "memory"); __builtin_amdgcn_s_barrier(); asm volatile("" ::: "memory"); } while (0)

typedef short bf16x8_t __attribute__((ext_vector_type(8)));
#define XB_TMO      128
#define XB_XCNT(j)  (256  + 64 * (j))
#define XB_XSUB(j)  (1280 + 64 * (j))
#define XB_XGEN(j)  (2304 + 64 * (j))
#define XB_TOP      3328
#define XB_TOPGEN   3392
#define XCD_BAR_WORDS 3456
#define XB_SPIN_CAP (1u << 18)

__device__ __forceinline__ unsigned xb_ld(unsigned* p)              { return __hip_atomic_load(p, __ATOMIC_RELAXED, __HIP_MEMORY_SCOPE_AGENT); }
__device__ __forceinline__ unsigned xb_add(unsigned* p, unsigned v) { return __hip_atomic_fetch_add(p, v, __ATOMIC_RELAXED, __HIP_MEMORY_SCOPE_AGENT); }
__device__ __forceinline__ unsigned xb_xcc_id() { return (unsigned)__builtin_amdgcn_s_getreg((3 << 11) | 20) & 0xFu; }
#define XB_SPIN(cond, bar) do { unsigned _sp = 0; while (cond) { __builtin_amdgcn_s_sleep(1); \
    if ((++_sp & 255u) == 0u) { if (xb_ld(&(bar)[XB_TMO])) break; if (_sp > XB_SPIN_CAP) { atomicAdd(&(bar)[XB_TMO], 1u); break; } } } } while (0)

struct XcdBarrier {
    unsigned* bar; unsigned x;
    volatile LAS unsigned* st;
};

__device__ __forceinline__ XcdBarrier xcd_barrier_post(unsigned* bar, volatile LAS unsigned* st) {
    XcdBarrier b; b.bar = bar; b.x = xb_xcc_id(); b.st = st;
    if (threadIdx.x == 0) (void)xb_add(&bar[XB_XCNT(b.x)], 1u);
    return b;
}
__device__ __forceinline__ void xcd_barrier_complete(unsigned* bar, unsigned x, unsigned& nloc, unsigned& nx) {
    const unsigned G = gridDim.x * gridDim.y * gridDim.z;
    unsigned sum, cnt, mine, sp = 0u;
    for (;;) {
        sum = 0u; cnt = 0u; mine = 0u;
#pragma unroll
        for (unsigned j = 0; j < 16; ++j) { const unsigned c = xb_ld(&bar[XB_XCNT(j)]); sum += c; cnt += (c > 0u) ? 1u : 0u; mine = (j == x) ? c : mine; }
        if (sum == G) break;
        __builtin_amdgcn_s_sleep(1);
        if ((++sp & 255u) == 0u) { if (xb_ld(&bar[XB_TMO])) break; if (sp > XB_SPIN_CAP) { atomicAdd(&bar[XB_TMO], 1u); break; } }
    }
    nloc = mine > 0u ? mine : 1u; nx = cnt > 0u ? cnt : 1u;
}

__device__ __forceinline__ void xcd_barrier(const XcdBarrier& b) {
    asm volatile("s_waitcnt vmcnt(0)" ::: "memory");
    __syncthreads();
    if (threadIdx.x == 0) {
        unsigned* bar = b.bar;
        __builtin_amdgcn_s_waitcnt(0);
        unsigned nloc = b.st[0], nx = b.st[1];
        if (nloc == 0u) { xcd_barrier_complete(bar, b.x, nloc, nx); b.st[0] = nloc; b.st[1] = nx; }
        const unsigned old = xb_add(&bar[XB_XSUB(b.x)], 1u);
        const unsigned gen = old / nloc;
        if (old + 1u == (gen + 1u) * nloc) {
            __builtin_amdgcn_fence(__ATOMIC_RELEASE, "agent");
            asm volatile("s_waitcnt vmcnt(0)" ::: "memory");
            const unsigned og = xb_add(&bar[XB_TOP], 1u);
            const unsigned tg = og / nx;
            if (og + 1u == (tg + 1u) * nx) xb_add(&bar[XB_TOPGEN], 1u);
            else XB_SPIN(xb_ld(&bar[XB_TOPGEN]) == tg, bar);
            __builtin_amdgcn_fence(__ATOMIC_ACQUIRE, "agent");
            xb_add(&bar[XB_XGEN(b.x)], 1u);
            asm volatile("s_waitcnt vmcnt(0)" ::: "memory");
        } else {
            XB_SPIN(xb_ld(&bar[XB_XGEN(b.x)]) == gen, bar);
            __builtin_amdgcn_fence(__ATOMIC_ACQUIRE, "agent");
            asm volatile("s_waitcnt vmcnt(0)" ::: "memory");
        }
    }
    __syncthreads();
}

__device__ __forceinline__ int fresh_tid() { int t = threadIdx.x; asm volatile("" : "+v"(t)); return t; }
#define PHASE_IDS const int tid = fresh_tid(), lane = tid & 63, wave = __builtin_amdgcn_readfirstlane(tid >> 6); (void)lane; (void)wave;
struct Args { const float* in[22]; float* out; unsigned char* ws; int ph_lo, ph_hi; };

__device__ __forceinline__ void tr_load(f32x4 (&v)[8], const float* __restrict__ W, int ldw, int k0, int n0, int lane) {
    const float* src = W + (size_t)(k0 + (lane >> 3)) * ldw + n0 + 4 * (lane & 7);
#pragma unroll
    for (int i = 0; i < 8; ++i) v[i] = __builtin_nontemporal_load((const f32x4*)(src + (size_t)(8 * i) * ldw));
}
__device__ __forceinline__ void tr_finish(const f32x4 (&v)[8], int k0, bf16_t* WTrow0, int ldk, LAS float* scr, int lane) {
#pragma unroll
    for (int i = 0; i < 8; ++i) { LAS float* d = scr + (8 * i + (lane >> 3)) * 33 + 4 * (lane & 7); d[0] = v[i][0]; d[1] = v[i][1]; d[2] = v[i][2]; d[3] = v[i][3]; }
    LDS_WAIT(); asm volatile("" ::: "memory");
    const int c = lane & 7;
#pragma unroll
    for (int j = 0; j < 4; ++j) { const int n = (lane >> 3) + 8 * j; const LAS float* s = scr + (8 * c) * 33 + n;
        v4u o; o.x = pk2(s[0 * 33], s[1 * 33]); o.y = pk2(s[2 * 33], s[3 * 33]); o.z = pk2(s[4 * 33], s[5 * 33]); o.w = pk2(s[6 * 33], s[7 * 33]);
        *(v4u*)(WTrow0 + (size_t)n * ldk + k0 + 8 * c) = o; }
    LDS_WAIT(); asm volatile("" ::: "memory");
}
__device__ __forceinline__ void tr_item(const float* __restrict__ W, int ldw, int k0, int n0, bf16_t* WTrow0, int ldk, LAS float* scr, int lane) {
    f32x4 v[8]; tr_load(v, W, ldw, k0, n0, lane); tr_finish(v, k0, WTrow0, ldk, scr, lane);
}
struct TrDesc { const float* W; int ldw, k0, n0, ldk; bf16_t* dst; };
__device__ __forceinline__ TrDesc tr_expert_desc(int r, const float* weg, const float* weu, const float* wed, bf16_t* WGU, bf16_t* WDN) {
    TrDesc t; constexpr int I_G = 32 * 128;
    if (r < 2 * I_G) { const bool up = r >= I_G; const int rr = up ? r - I_G : r, e = rr >> 7, q = rr & 127, kb = q >> 3, nb = q & 7, n0 = 64 * nb;
        t.W = (up ? weu : weg) + (size_t)e * 1024 * 512; t.ldw = 512; t.k0 = 64 * kb; t.n0 = n0; t.ldk = 1024; t.dst = WGU + ((size_t)e * 1024 + 256 * (n0 >> 7) + (up ? 128 : 0) + (n0 & 127)) * 1024; }
    else { const int rr = r - 2 * I_G, e = rr >> 7, q = rr & 127, kb = q >> 4, nb = q & 15;
        t.W = wed + (size_t)e * 512 * 1024; t.ldw = 1024; t.k0 = 64 * kb; t.n0 = 64 * nb; t.ldk = 512; t.dst = WDN + ((size_t)e * 1024 + 64 * nb) * 512; }
    return t;
}
__device__ __forceinline__ void tr_load64(f32x4 (&v)[16], const TrDesc& t, int lane) {
    const float* src = t.W + (size_t)(t.k0 + (lane >> 4)) * t.ldw + t.n0 + 4 * (lane & 15);
#pragma unroll
    for (int i = 0; i < 16; ++i) v[i] = __builtin_nontemporal_load((const f32x4*)(src + (size_t)(4 * i) * t.ldw));
}
__device__ __forceinline__ void tr_finish64(const f32x4 (&v)[16], const TrDesc& t, LAS float* scr, int lane) {
#pragma unroll
    for (int i = 0; i < 16; ++i) { LAS float* d = scr + (4 * i + (lane >> 4)) * 65 + 4 * (lane & 15); d[0] = v[i][0]; d[1] = v[i][1]; d[2] = v[i][2]; d[3] = v[i][3]; }
    LDS_WAIT(); asm volatile("" ::: "memory");
    const int c = lane & 7;
#pragma unroll
    for (int j = 0; j < 8; ++j) { const int n = (lane >> 3) + 8 * j; const LAS float* s = scr + (8 * c) * 65 + n;
        v4u o; o.x = pk2(s[0 * 65], s[1 * 65]); o.y = pk2(s[2 * 65], s[3 * 65]); o.z = pk2(s[4 * 65], s[5 * 65]); o.w = pk2(s[6 * 65], s[7 * 65]);
        *(v4u*)(t.dst + (size_t)n * t.ldk + t.k0 + 8 * c) = o; }
    LDS_WAIT(); asm volatile("" ::: "memory");
}
__device__ __forceinline__ int win_vc0(int n0) {
    if (n0 < 512) { const int head = n0 >> 6, dh = (n0 >> 5) & 1; return 256 * (head >> 2) + 128 * dh + 32 * (head & 3); }
    if (n0 < 640) { const int hh = (n0 - 512) >> 6, dh = ((n0 - 512) >> 5) & 1; return 512 + 128 * dh + 32 * hh; }
    if (n0 < 768) { const int hv = (n0 - 640) >> 6, dh = ((n0 - 640) >> 5) & 1; return 512 + 128 * dh + 32 * (hv + 2); }
    return n0;
}


constexpr int HQ_LD = 136, HK_LD = 72;
constexpr int HA_RAWG = 0, HA_RAWQ = 16384, HA_RAWV = 32768, HA_QT = 49152, HA_KT = HA_QT + 64 * HQ_LD * 2, HA_KHT = HA_KT + 64 * HQ_LD * 2, HA_VT = HA_KHT + 128 * HK_LD * 2, HA_AM = HA_VT + 128 * HK_LD * 2, HA_END = HA_AM + 64 * HK_LD * 2;
static_assert(HA_END <= 131072, "HGRN phase A LDS");
typedef short v4i16_t __attribute__((ext_vector_type(4)));
__device__ __forceinline__ bf16x8_t tr_frag(const LAS bf16_t* T, int pitch, int row0, int col0, int ln) {
    const LAS bf16_t* p = T + (row0 + (ln >> 2)) * pitch + col0 + 4 * (ln & 3);
    const v4i16_t lo = __builtin_amdgcn_ds_read_tr16_b64_v4i16((LAS v4i16_t*)p), hi = __builtin_amdgcn_ds_read_tr16_b64_v4i16((LAS v4i16_t*)(p + 4 * pitch));
    return (bf16x8_t){lo[0], lo[1], lo[2], lo[3], hi[0], hi[1], hi[2], hi[3]};
}
__device__ __forceinline__ float fexp_c(float x) { return __expf(fminf(x, 80.f)); }
__device__ __forceinline__ void hgrn_a_load(v4u (&rg)[6], int unit, const bf16_t* __restrict__ QR, const bf16_t* GF, const bf16_t* GB, const bf16_t* __restrict__ IV, int tid) {
    const int c = unit % NCHUNK, dir = (unit / NCHUNK) & 1, h = (unit / (2 * NCHUNK)) & 3, b = unit / (8 * NCHUNK);
    const bf16_t* G = dir ? GB : GF; const size_t rowb = (size_t)b * TPB + 64 * c;
#pragma unroll
    for (int i = 0; i < 2; ++i) { const int p = tid + 512 * i, j = p >> 4, ch = p & 15; const size_t off = (rowb + (dir ? 63 - j : j)) * 512 + h * 128 + ch * 8;
        rg[i] = __builtin_nontemporal_load((const v4u*)(G + off)); rg[2 + i] = __builtin_nontemporal_load((const v4u*)(QR + off)); rg[4 + i] = __builtin_nontemporal_load((const v4u*)(IV + off)); }
}
__device__ __forceinline__ void hgrn_a_unit(int unit, int next_unit, v4u (&rg)[6], const bf16_t* __restrict__ QR, bf16_t* GF, bf16_t* GB, const bf16_t* __restrict__ IV, bf16_t* ORF, bf16_t* ORB, bf16_t* UT, float* DEC, LAS unsigned char* lds, LAS float* qs, int tid) {
    const int c = unit % NCHUNK, dir = (unit / NCHUNK) & 1, h = (unit / (2 * NCHUNK)) & 3, b = unit / (8 * NCHUNK);
    const bool lat = c >= 4;
    const int d = tid & 127, qt = tid >> 7, lane = tid & 63, wave = __builtin_amdgcn_readfirstlane(tid >> 6), ln = lane & 15, lg = lane >> 4;
    bf16_t* G = dir ? GB : GF; bf16_t* OR = dir ? ORB : ORF;
    LAS bf16_t* RG = (LAS bf16_t*)(lds + HA_RAWG); LAS bf16_t* RQ = (LAS bf16_t*)(lds + HA_RAWQ); LAS bf16_t* RV = (LAS bf16_t*)(lds + HA_KHT);
    LAS bf16_t* Qt = (LAS bf16_t*)(lds + HA_QT); LAS bf16_t* Kt = (LAS bf16_t*)(lds + HA_KT); LAS bf16_t* Am = (LAS bf16_t*)(lds + HA_AM);
    LAS float* cendT = qs + 1024;
    const size_t rowb = (size_t)b * TPB + 64 * c;
#pragma unroll
    for (int i = 0; i < 2; ++i) { const int p = tid + 512 * i; *(LAS v4u*)(RG + p * 8) = rg[i]; *(LAS v4u*)(RQ + p * 8) = rg[2 + i]; *(LAS v4u*)(RV + (p >> 4) * HQ_LD + (p & 15) * 8) = rg[4 + i]; }
    LBAR();
    typedef float f2 __attribute__((ext_vector_type(2)));
    const int dp = lane, d2 = 2 * dp, r8 = 8 * wave;
    f2 g[8], q[8];
#pragma unroll
    for (int i = 0; i < 8; ++i) {
        const int j = r8 + i;
        const unsigned gw_ = *(const LAS unsigned*)(RG + j * 128 + d2), qw_ = *(const LAS unsigned*)(RQ + j * 128 + d2);
        g[i] = (f2){__uint_as_float(gw_ << 16), __uint_as_float(gw_ & 0xffff0000u)}; q[i] = (f2){__uint_as_float(qw_ << 16), __uint_as_float(qw_ & 0xffff0000u)};
    }
    f2 bl[8]; f2 run = (f2){0.f, 0.f};
#pragma unroll
    for (int i = 0; i < 8; ++i) { run += g[i]; bl[i] = run; }
    *(LAS f2*)(qs + wave * 128 + d2) = run;
    LBAR();
    if (next_unit >= 0) hgrn_a_load(rg, next_unit, QR, GF, GB, IV, tid);
    f2 off = (f2){0.f, 0.f}, bmid = (f2){0.f, 0.f}, bend = (f2){0.f, 0.f};
#pragma unroll
    for (int w = 0; w < 8; ++w) { const f2 t = *(const LAS f2*)(qs + w * 128 + d2); if (w < wave) off += t; if (w < 4) bmid += t; bend += t; }
    const f2 cmid = (f2){__expf(bmid.x), __expf(bmid.y)}, cend = (f2){__expf(bend.x - bmid.x), __expf(bend.y - bmid.y)};
#pragma unroll
    for (int i = 0; i < 8; ++i) {
        const int j = r8 + i; const f2 bb = off + bl[i];
        const f2 k = (f2){1.f - __expf(g[i].x), 1.f - __expf(g[i].y)};
        const f2 e1 = (f2){__expf(fminf(fmaxf(bb.x - bmid.x, -80.f), 80.f)), __expf(fminf(fmaxf(bb.y - bmid.y, -80.f), 80.f))};
        const f2 qt_ = q[i] * e1, kt_ = k * (f2){__builtin_amdgcn_rcpf(e1.x), __builtin_amdgcn_rcpf(e1.y)};
        const f2 qh = qt_ * cmid;
        *(LAS unsigned*)(RG + j * 128 + d2) = pk2(qh.x, qh.y);
        *(LAS unsigned*)(Qt + j * HQ_LD + d2) = pk2(qt_.x, qt_.y);
        *(LAS unsigned*)(Kt + j * HQ_LD + d2) = pk2(kt_.x, kt_.y);
    }
    if (wave == 0) { *(f2*)(DEC + (size_t)unit * 128 + d2) = (f2){__expf(bend.x), __expf(bend.y)}; *(LAS f2*)(cendT + d2) = cend; }
    LBAR();
    if (lat) {
#pragma unroll
        for (int i = 0; i < 2; ++i) { const int p = tid + 512 * i, j = p >> 4, ch = p & 15; *(v4u*)(G + (rowb + (dir ? 63 - j : j)) * 512 + h * 128 + ch * 8) = *(const LAS v4u*)(RG + p * 8); }
    }
    {
        const int jb = wave >> 1;
#pragma unroll
        for (int sbi = 0; sbi < 2; ++sbi) {
            const int sb = 2 * (wave & 1) + sbi;
            f32x4 acc = (f32x4){0.f, 0.f, 0.f, 0.f};
#pragma unroll
            for (int ks = 0; ks < 4; ++ks) {
                const bf16x8_t af = *(const LAS bf16x8_t*)(Qt + (16 * jb + ln) * HQ_LD + 32 * ks + 8 * lg);
                const bf16x8_t bf = *(const LAS bf16x8_t*)(Kt + (16 * sb + ln) * HQ_LD + 32 * ks + 8 * lg);
                acc = __builtin_amdgcn_mfma_f32_16x16x32_bf16(af, bf, acc, 0, 0, 0);
            }
#pragma unroll
            for (int rg2 = 0; rg2 < 4; ++rg2) { const int j = 16 * jb + 4 * lg + rg2, sidx = 16 * sb + ln; Am[j * HK_LD + sidx] = f2bf(sidx <= j ? acc[rg2] : 0.f); }
        }
    }
    LBAR();
    {
        const int vb = wave;
        bf16x8_t vf[2];
#pragma unroll
        for (int ks = 0; ks < 2; ++ks) vf[ks] = tr_frag(RV, HQ_LD, 32 * ks + 8 * lg, 16 * vb, ln);
        if (lat) {
            LAS bf16_t* stg = (LAS bf16_t*)(lds + HA_QT + wave * 2048);
#pragma unroll
            for (int jb = 0; jb < 4; ++jb) {
                f32x4 acc = (f32x4){0.f, 0.f, 0.f, 0.f};
#pragma unroll
                for (int ks = 0; ks < 2; ++ks) { const bf16x8_t af = *(const LAS bf16x8_t*)(Am + (16 * jb + ln) * HK_LD + 32 * ks + 8 * lg); acc = __builtin_amdgcn_mfma_f32_16x16x32_bf16(af, vf[ks], acc, 0, 0, 0); }
#pragma unroll
                for (int rg2 = 0; rg2 < 4; ++rg2) stg[(16 * jb + 4 * lg + rg2) * 16 + ln] = f2bf(acc[rg2]);
            }
        }
        LAS unsigned char* ust = (LAS unsigned char*)(lds + HA_RAWQ + wave * 2048);
#pragma unroll
        for (int db = 0; db < 8; ++db) {
            f32x4 acc = (f32x4){0.f, 0.f, 0.f, 0.f};
#pragma unroll
            for (int ks = 0; ks < 2; ++ks) { const bf16x8_t kf = tr_frag(Kt, HQ_LD, 32 * ks + 8 * lg, 16 * db, ln); acc = __builtin_amdgcn_mfma_f32_16x16x32_bf16(kf, vf[ks], acc, 0, 0, 0); }
            const f32x4 ce = *(const LAS f32x4*)(cendT + 16 * db + 4 * lg);
            *(LAS unsigned*)(ust + ln * 128 + 16 * db + 4 * lg) = pack4_fp8(acc[0] * ce[0], acc[1] * ce[1], acc[2] * ce[2], acc[3] * ce[3]);
        }
    }
    asm volatile("s_waitcnt lgkmcnt(0)" ::: "memory");
    {
        const int vb = wave;
        if (lat) {
            const LAS bf16_t* stg = (const LAS bf16_t*)(lds + HA_QT + wave * 2048);
#pragma unroll
            for (int i = 0; i < 2; ++i) { const int qq = lane + 64 * i, j = qq >> 1, hf = qq & 1; const size_t tok = (size_t)b * SEQ + 64 * (c - 4) + (dir ? 63 - j : j);
                *(v4u*)(OR + tok * 512 + h * 128 + 16 * vb + 8 * hf) = *(const LAS v4u*)(stg + j * 16 + 8 * hf); }
        }
        const LAS unsigned char* ust = (const LAS unsigned char*)(lds + HA_RAWQ + wave * 2048);
        unsigned char* ut = (unsigned char*)UT + (size_t)unit * 16384 + (size_t)(16 * vb) * 128;
#pragma unroll
        for (int i = 0; i < 2; ++i) { const int qq = lane + 64 * i, r = qq >> 3, ch = qq & 7; *(v4u*)(ut + r * 128 + ch * 16) = *(const LAS v4u*)(ust + r * 128 + ch * 16); }
    }
    LBAR();
}
__device__ __forceinline__ int hb_chunk(int dir, int st) { return dir == 0 ? st : (st < 4 ? 3 - st : 71 - st); }
__device__ __forceinline__ void hgrn_scan(int gw, bf16_t* UT, const float* __restrict__ DEC, int lane) {
    const int chain = gw >> 5, slice = gw & 31, dir = chain & 1, ubase = chain * NCHUNK;
    unsigned char* U8 = (unsigned char*)UT;
    const size_t eoff = (size_t)(4 * slice + (lane >> 4)) * 128 + 8 * (lane & 15);
    const int doff = 8 * (lane & 15);
    float S[8];
#pragma unroll
    for (int i = 0; i < 8; ++i) S[i] = 0.f;
    for (int st = 0; st < NCHUNK; st += 4) {
        v2u u[4]; f32x4 a[4][2];
#pragma unroll
        for (int k = 0; k < 4; ++k) { const int c = hb_chunk(dir, st + k); u[k] = *(const v2u*)(U8 + (size_t)(ubase + c) * 16384 + eoff); a[k][0] = *(const f32x4*)(DEC + (size_t)(ubase + c) * 128 + doff); a[k][1] = *(const f32x4*)(DEC + (size_t)(ubase + c) * 128 + doff + 4); }
#pragma unroll
        for (int k = 0; k < 4; ++k) {
            const int c = hb_chunk(dir, st + k);
            float u0[4], u1[4]; unpack4_fp8(u[k].x, u0); unpack4_fp8(u[k].y, u1);
#pragma unroll
            for (int p = 0; p < 4; ++p) { S[p] = a[k][0][p] * S[p] + u0[p]; S[4 + p] = a[k][1][p] * S[4 + p] + u1[p]; }
            v2u o; o.x = pack4_fp8(S[0], S[1], S[2], S[3]); o.y = pack4_fp8(S[4], S[5], S[6], S[7]);
            *(v2u*)(U8 + (size_t)(ubase + c) * 16384 + eoff) = o;
        }
    }
}
constexpr int HC_IS = 0, HC_RED = 16384, HC_RSTD = 18432, HC_QF = 20480, HC_QB = HC_QF + 64 * HQ_LD * 2, HC_END = HC_QB + 64 * HQ_LD * 2;
static_assert(HC_END <= 131072, "phase C LDS");
struct HcPre { v4u inf[2], inb[2], gr[2], qf[2], qb[2]; v2u sf[2][4]; };
__device__ __forceinline__ void hgrn_c_load(HcPre& P, int uid, const bf16_t* __restrict__ QF, const bf16_t* __restrict__ QB, const bf16_t* ORF, const bf16_t* __restrict__ ORB, const bf16_t* __restrict__ UT, const bf16_t* __restrict__ GR, int tid) {
    const int c = 4 + (uid & 63), h = (uid >> 6) & 3, b = uid >> 8;
    const int lane = tid & 63, vb = tid >> 6, ln = lane & 15, lg = lane >> 4;
    const size_t rowb = (size_t)b * TPB + 64 * c, tokb = (size_t)b * SEQ + 64 * (c - 4);
    const int usf = ((b * 4 + h) * 2 + 0) * NCHUNK + (c - 1), usb = ((b * 4 + h) * 2 + 1) * NCHUNK + (c == NCHUNK - 1 ? 0 : c + 1);
#pragma unroll
    for (int i = 0; i < 2; ++i) {
        const int p = tid + 512 * i, t = p >> 4, ch = p & 15; const size_t off = (tokb + t) * 512 + h * 128 + ch * 8, qoff = (rowb + t) * 512 + h * 128 + ch * 8;
        P.inf[i] = __builtin_nontemporal_load((const v4u*)(ORF + off)); P.inb[i] = __builtin_nontemporal_load((const v4u*)(ORB + off)); P.gr[i] = __builtin_nontemporal_load((const v4u*)(GR + off)); P.qf[i] = __builtin_nontemporal_load((const v4u*)(QF + qoff)); P.qb[i] = __builtin_nontemporal_load((const v4u*)(QB + qoff));
    }
#pragma unroll
    for (int ks = 0; ks < 4; ++ks) { P.sf[0][ks] = *(const v2u*)((const unsigned char*)UT + (size_t)usf * 16384 + (size_t)(16 * vb + ln) * 128 + 32 * ks + 8 * lg); P.sf[1][ks] = *(const v2u*)((const unsigned char*)UT + (size_t)usb * 16384 + (size_t)(16 * vb + ln) * 128 + 32 * ks + 8 * lg); }
}
__device__ __forceinline__ void hgrn_c_unit(int uid, int next_uid, HcPre& P, const bf16_t* __restrict__ QF, const bf16_t* __restrict__ QB, bf16_t* ORF, const bf16_t* __restrict__ ORB, const bf16_t* __restrict__ UT, const bf16_t* __restrict__ GR,
                                            const float* __restrict__ hg, LAS unsigned char* lds, int tid) {
    const int c = 4 + (uid & 63), h = (uid >> 6) & 3, b = uid >> 8;
    const int lane = tid & 63, vb = __builtin_amdgcn_readfirstlane(tid >> 6), ln = lane & 15, lg = lane >> 4;
    const size_t tokb = (size_t)b * SEQ + 64 * (c - 4);
    LAS bf16_t* IS = (LAS bf16_t*)(lds + HC_IS); LAS float* RED = (LAS float*)(lds + HC_RED); LAS float* RSTD = (LAS float*)(lds + HC_RSTD);
    LAS bf16_t* QFs = (LAS bf16_t*)(lds + HC_QF); LAS bf16_t* QBs = (LAS bf16_t*)(lds + HC_QB);
    v4u grv[2]; bf16x8_t sf[2][4];
#pragma unroll
    for (int i = 0; i < 2; ++i) {
        const int p = tid + 512 * i, t = p >> 4, ch = p & 15;
        const unsigned wf[4] = {P.inf[i].x, P.inf[i].y, P.inf[i].z, P.inf[i].w}, wq[4] = {P.inb[i].x, P.inb[i].y, P.inb[i].z, P.inb[i].w}; v4u o;
        o.x = pg8::cvt_pk_bf16(__uint_as_float(wf[0] << 16) + __uint_as_float(wq[0] << 16), __uint_as_float(wf[0] & 0xffff0000u) + __uint_as_float(wq[0] & 0xffff0000u));
        o.y = pg8::cvt_pk_bf16(__uint_as_float(wf[1] << 16) + __uint_as_float(wq[1] << 16), __uint_as_float(wf[1] & 0xffff0000u) + __uint_as_float(wq[1] & 0xffff0000u));
        o.z = pg8::cvt_pk_bf16(__uint_as_float(wf[2] << 16) + __uint_as_float(wq[2] << 16), __uint_as_float(wf[2] & 0xffff0000u) + __uint_as_float(wq[2] & 0xffff0000u));
        o.w = pg8::cvt_pk_bf16(__uint_as_float(wf[3] << 16) + __uint_as_float(wq[3] << 16), __uint_as_float(wf[3] & 0xffff0000u) + __uint_as_float(wq[3] & 0xffff0000u));
        *(LAS v4u*)(IS + p * 8) = o;
        *(LAS v4u*)(QFs + t * HQ_LD + ch * 8) = P.qf[i]; *(LAS v4u*)(QBs + t * HQ_LD + ch * 8) = P.qb[i];
        grv[i] = P.gr[i];
    }
#pragma unroll
    for (int ks = 0; ks < 4; ++ks)
#pragma unroll
        for (int dd = 0; dd < 2; ++dd) { float lo[4], hi[4]; unpack4_fp8(P.sf[dd][ks].x, lo); unpack4_fp8(P.sf[dd][ks].y, hi);
            v4u w; w.x = pk2(lo[0], lo[1]); w.y = pk2(lo[2], lo[3]); w.z = pk2(hi[0], hi[1]); w.w = pk2(hi[2], hi[3]); sf[dd][ks] = __builtin_bit_cast(bf16x8_t, w); }
    LBAR();
    if (next_uid >= 0) hgrn_c_load(P, next_uid, QF, QB, ORF, ORB, UT, GR, tid);
#pragma unroll
    for (int jb = 0; jb < 4; ++jb) {
        f32x4 acc;
#pragma unroll
        for (int rg = 0; rg < 4; ++rg) acc[rg] = bf2f(IS[(16 * jb + 4 * lg + rg) * 128 + 16 * vb + ln]);
#pragma unroll
        for (int ks = 0; ks < 4; ++ks) {
            acc = __builtin_amdgcn_mfma_f32_16x16x32_bf16(*(const LAS bf16x8_t*)(QFs + (16 * jb + ln) * HQ_LD + 32 * ks + 8 * lg), sf[0][ks], acc, 0, 0, 0);
            acc = __builtin_amdgcn_mfma_f32_16x16x32_bf16(*(const LAS bf16x8_t*)(QBs + (16 * jb + ln) * HQ_LD + 32 * ks + 8 * lg), sf[1][ks], acc, 0, 0, 0);
        }
#pragma unroll
        for (int rg = 0; rg < 4; ++rg) IS[(16 * jb + 4 * lg + rg) * 128 + 16 * vb + ln] = f2bf(acc[rg]);
    }
    LBAR();
    const f32x4 hg0 = *(const f32x4*)(hg + h * 128 + (tid & 15) * 8), hg1 = *(const f32x4*)(hg + h * 128 + (tid & 15) * 8 + 4);
#pragma unroll
    for (int i = 0; i < 2; ++i) {
        const int p = tid + 512 * i, t = p >> 4, ch = p & 15;
        const v4u sv = *(const LAS v4u*)(IS + p * 8);
        const unsigned ws_[4] = {sv.x, sv.y, sv.z, sv.w}, wg[4] = {grv[i].x, grv[i].y, grv[i].z, grv[i].w};
        float x[8]; float ss = 0.f;
#pragma unroll
        for (int q = 0; q < 4; ++q) { x[2 * q] = __uint_as_float(ws_[q] << 16); x[2 * q + 1] = __uint_as_float(ws_[q] & 0xffff0000u); ss += x[2 * q] * x[2 * q] + x[2 * q + 1] * x[2 * q + 1]; }
        ss += __shfl_xor(ss, 1); ss += __shfl_xor(ss, 2); ss += __shfl_xor(ss, 4); ss += __shfl_xor(ss, 8);
        const float rs = rsqrtf(ss * (1.f / 128.f) + EPS);
        v4u ov;
        ov.x = pk2(x[0] * rs * hg0[0] * __uint_as_float(wg[0] << 16), x[1] * rs * hg0[1] * __uint_as_float(wg[0] & 0xffff0000u));
        ov.y = pk2(x[2] * rs * hg0[2] * __uint_as_float(wg[1] << 16), x[3] * rs * hg0[3] * __uint_as_float(wg[1] & 0xffff0000u));
        ov.z = pk2(x[4] * rs * hg1[0] * __uint_as_float(wg[2] << 16), x[5] * rs * hg1[1] * __uint_as_float(wg[2] & 0xffff0000u));
        ov.w = pk2(x[6] * rs * hg1[2] * __uint_as_float(wg[3] << 16), x[7] * rs * hg1[3] * __uint_as_float(wg[3] & 0xffff0000u));
        *(v4u*)(ORF + (tokb + t) * 512 + h * 128 + ch * 8) = ov;
    }
    LBAR();
}

constexpr int CW_CNT = 8192;
__device__ __forceinline__ int build_tiles(const int* ctl, LAS int* segt, LAS int* tile_e, LAS int* cntl, int tid) {
    __syncthreads();
    if (tid < 64) {
        const int c = tid < 32 ? ctl[CW_CNT + 64 * tid] : 0, nt = (c + 255) >> 8;
        int p = nt;
#pragma unroll
        for (int o = 1; o < 32; o <<= 1) { const int t = __shfl_up(p, o); if (tid >= o) p += t; }
        const int start = p - nt;
        if (tid < 32) { segt[tid] = start; cntl[tid] = c; for (int i = 0; i < nt; ++i) tile_e[start + i] = tid; }
        if (tid == 31) segt[32] = p;
    }
    __syncthreads();
    return segt[32];
}

__global__ void __launch_bounds__(NWAVES * 64, 2) mk_fwd(Args a) {
    extern __shared__ __attribute__((aligned(16))) unsigned char lds[];
    cg::grid_group grid = cg::this_grid();
    const int tid = threadIdx.x, lane = tid & 63, wave = __builtin_amdgcn_readfirstlane(tid >> 6);
    const int G = gridDim.x, bx = blockIdx.x;
    unsigned char* ws = a.ws;
    const float* x = a.in[0]; const float* c = a.in[1]; const float* ctx = a.in[2]; const float* c_ctx = a.in[3];
    const float* w_ada = a.in[4]; const float* b_ada = a.in[5]; const float* norm1_g = a.in[6];
    const float* w_in = a.in[8]; const float* q_norm_g = a.in[9]; const float* k_norm_g = a.in[10];
    const float* hgrn_lb = a.in[12]; const float* w_out = a.in[14];
    const float* weg = a.in[19]; const float* weu = a.in[20]; const float* wed = a.in[21];
    float* mod = (float*)(ws + WS_MOD); float* lb = (float*)(ws + WS_MOD + 256 * 1024);
    bf16_t* WT_IN = (bf16_t*)(ws + WS_WTIN); bf16_t* WT_OUT = (bf16_t*)(ws + WS_WTOUT); bf16_t* WGU = (bf16_t*)((unsigned char*)a.out + OUT_WGU); bf16_t* WDN = (bf16_t*)((unsigned char*)a.out + OUT_WDN);
    bf16_t* DL = (bf16_t*)(ws + WS_DL);
    bf16_t* H = (bf16_t*)(ws + WS_H);

#if defined(TIME_A)
    if (TIME_A >= 0 && blockIdx.x == 0 && threadIdx.x == 0) ((volatile LAS unsigned long long*)(lds + MISC_OFF + 4608))[15] = __builtin_amdgcn_s_memrealtime();
#endif
    {
        LAS float* rt = (LAS float*)(lds + ROPE_OFF);
        for (int i = tid; i < 1024; i += NWAVES * 64) { const int pos = i >> 4, f = i & 15; const float ang = (float)pos * powf(10000.0f, -(float)f * (1.0f / 16.0f)); rt[2 * i] = cosf(ang); rt[2 * i + 1] = sinf(ang); }
    }
    const int ph_lo = a.ph_lo, ph_hi = a.ph_hi;
#ifndef TIME_A
#define TIME_A -1
#endif
#ifndef TIME_B
#define TIME_B 0
#endif
#define STAMP(i) do { if (TIME_A >= 0 && bx == 0 && tid == 0) ((volatile LAS unsigned long long*)(lds + MISC_OFF + 4608))[i] = __builtin_amdgcn_s_memrealtime(); } while (0)
    STAMP(0);
    if (ph_lo > 1000) grid.sync();
#define IN(k) (ph_lo <= (k) && (k) < ph_hi)
#define SEAM(k) do { if (IN(k) && IN((k) + 1)) { xcd_barrier(xbar); } } while (0)
    if (tid < 2) ((volatile LAS unsigned*)(lds + MISC_OFF + 4096))[tid] = 0u;
    __syncthreads();
    XcdBarrier xbar = xcd_barrier_post((unsigned*)(ws + WS_CTL) + 4096, (volatile LAS unsigned*)(lds + MISC_OFF + 4096));
    if (IN(0)) {
        PHASE_IDS
    if (bx < 192) {
        LAS float* s = (LAS float*)lds; LAS float* part = (LAS float*)(lds + 40960);
        for (int i = tid; i < 9 * 1024; i += NWAVES * 64) { const int r = i >> 10, k = i & 1023; const float v = r < 8 ? c[r * 1024 + k] : c_ctx[k]; s[i] = v / (1.f + expf(-v)); }
        __syncthreads();
        const int j = tid & 31, ks = tid >> 5, j0 = bx * 32;
        float acc[9];
#pragma unroll
        for (int r = 0; r < 9; ++r) acc[r] = 0.f;
#pragma unroll
        for (int kb = 0; kb < 2; ++kb) {
            float w[32];
#pragma unroll
            for (int kk = 0; kk < 32; ++kk) w[kk] = __builtin_nontemporal_load(w_ada + (size_t)(ks * 64 + kb * 32 + kk) * 6144 + j0 + j);
#pragma unroll
            for (int kk = 0; kk < 32; ++kk) { const int k = ks * 64 + kb * 32 + kk;
#pragma unroll
                for (int r = 0; r < 9; ++r) acc[r] += s[r * 1024 + k] * w[kk]; }
        }
#pragma unroll
        for (int r = 0; r < 9; ++r) part[(ks * 9 + r) * 32 + j] = acc[r];
        __syncthreads();
        if (tid < 288) { const int r = tid >> 5, jj = tid & 31; float sum = b_ada[j0 + jj];
            for (int q = 0; q < 16; ++q) sum += part[(q * 9 + r) * 32 + jj];
            mod[r * 6144 + j0 + jj] = sum; }
    }
    if (bx >= 192 && bx < G - 1) {
        const int nw = (G - 1 - 192) * NWAVES, wi = (bx - 192) * NWAVES + wave;
        const f32x4* xp = (const f32x4*)x;
        constexpr size_t NPF = (size_t)NLAT * D / 4 * 4 / 8;
        for (size_t p = (size_t)wi * 64 + lane; p < NPF; p += (size_t)nw * 64 * 8) {
            f32x4 t[8];
#pragma unroll
            for (int q = 0; q < 8; ++q) { const size_t pp = p + (size_t)q * nw * 64; t[q] = pp < NPF ? xp[pp] : (f32x4){0.f, 0.f, 0.f, 0.f}; }
#pragma unroll
            for (int q = 0; q < 8; ++q) asm volatile("" :: "v"(t[q]));
        }
    }
    if (bx == G - 1) {
        for (int i = tid; i < 1024; i += NWAVES * 64) { const int d = i >> 9, w = i & 511; const float l0 = hgrn_lb[(d * 2 + 0) * 512 + w], l1 = hgrn_lb[(d * 2 + 1) * 512 + w]; lb[i] = 1.f / (1.f + expf(l1 - l0)); }
        bf16_t* WRT = (bf16_t*)(ws + WS_WRT);
        for (int i = tid; i < 48 * 1024; i += NWAVES * 64) { const int n = i >> 10, k = i & 1023; const float v = n < 4 ? a.in[15][k * 4 + n] : (n < 36 ? a.in[17][k * 32 + (n - 4)] : 0.f); WRT[i] = f2bf(v); }
    }
    __syncthreads();
    {
        LAS float* scr = (LAS float*)(lds + RING_OFF + wave * 16384);
        const int gw = bx * NWAVES + wave, NGW = G * NWAVES;
        constexpr int I_IN = 16 * 104, I_OUT = 16 * 32;
        for (int it = gw; it < I_IN + I_OUT; it += NGW) {
            int r = it;
            if (r < I_IN) { const int kb = r / 104, nb = r % 104; tr_item(w_in, PW, 64 * kb, 32 * nb, WT_IN + (size_t)win_vc0(32 * nb) * 1024, 1024, scr, lane); continue; } r -= I_IN;
            { const int kb = r / 32, nb = r % 32; tr_item(w_out, 1024, 64 * kb, 32 * nb, WT_OUT + (size_t)(32 * nb) * 1024, 1024, scr, lane); }
        }
    }
    }
    SEAM(0);
    STAMP(1);
    if (IN(1)) {
        PHASE_IDS
        const int gw = bx * NWAVES + wave, NGW = G * NWAVES;
#define MOD_ROWS(NR, ROW0) do { const int row0_ = (ROW0), b_ = row0_ / TPB, pos_ = row0_ % TPB; \
            const float* src_ = pos_ < CTX ? ctx + ((size_t)b_ * CTX + pos_) * D : x + ((size_t)b_ * SEQ + (pos_ - CTX)) * D; \
            const float* m_ = mod + (pos_ < CTX ? 8 : b_) * 6144; \
            f32x4 v_[NR][4], ga_[4], sh_[4]; \
            _Pragma("unroll") for (int r = 0; r < NR; ++r) _Pragma("unroll") for (int j = 0; j < 4; ++j) v_[r][j] = __builtin_nontemporal_load((const f32x4*)(src_ + (size_t)r * D + 512 * (j >> 1) + 8 * lane + 4 * (j & 1))); \
            _Pragma("unroll") for (int j = 0; j < 4; ++j) { const int k = 512 * (j >> 1) + 8 * lane + 4 * (j & 1); const f32x4 g = *(const f32x4*)(norm1_g + k), sc = *(const f32x4*)(m_ + 1024 + k); sh_[j] = *(const f32x4*)(m_ + k); ga_[j] = g * (1.f + sc); } \
            _Pragma("unroll") for (int r = 0; r < NR; ++r) { float ss = 0.f; \
                _Pragma("unroll") for (int j = 0; j < 4; ++j) ss += (v_[r][j][0] * v_[r][j][0] + v_[r][j][1] * v_[r][j][1]) + (v_[r][j][2] * v_[r][j][2] + v_[r][j][3] * v_[r][j][3]); \
                const float rstd = rsqrtf(wave_sum(ss) * (1.f / D) + EPS); \
                _Pragma("unroll") for (int hh = 0; hh < 2; ++hh) { const f32x4 o0 = v_[r][2 * hh] * rstd * ga_[2 * hh] + sh_[2 * hh], o1 = v_[r][2 * hh + 1] * rstd * ga_[2 * hh + 1] + sh_[2 * hh + 1]; \
                    v4u pk; pk.x = pk2(o0[0], o0[1]); pk.y = pk2(o0[2], o0[3]); pk.z = pk2(o1[0], o1[1]); pk.w = pk2(o1[2], o1[3]); \
                    *(v4u*)(H + (size_t)(row0_ + r) * D + 512 * hh + 8 * lane) = pk; } } } while (0)
        for (int i = 0; i < 4; ++i) { const int grp = gw + i * NGW; if (4 * grp + 3 < NROW) MOD_ROWS(4, 4 * grp); }
        for (int row = 16 * NGW + gw; row < NROW; row += NGW) MOD_ROWS(1, row);
#undef MOD_ROWS
    }
    SEAM(1);
    STAMP(2);
    if (IN(2)) {
        PHASE_IDS
        pg8::Gemm g{H, WT_IN, NROW, PW, D}; pg8::StaticOrder S; S.init(NROW, PW, G, bx);
        LAS float* etab = (LAS float*)(lds + XTRA_OFF);
        for (int i = tid; i < 1152; i += NWAVES * 64) etab[i] = i < 64 ? q_norm_g[i] : (i < 128 ? k_norm_g[i - 64] : lb[i - 128]);
        __syncthreads();
        pg8::EpiInproj E{(bf16_t*)(ws + WS_QA), (bf16_t*)(ws + WS_KA), (bf16_t*)(ws + WS_VA), (bf16_t*)(ws + WS_QR), (bf16_t*)(ws + WS_GF), (bf16_t*)(ws + WS_GB),
                         (bf16_t*)(ws + WS_IV), (bf16_t*)(ws + WS_GR), etab, etab + 64, etab + 128, (const LAS pg8::f32x2*)(lds + ROPE_OFF)};
        pg8::gemm_phase<pg8::EpiInproj, pg8::StaticOrder, true, true>((LAS unsigned char*)lds + RING_OFF, g, S, E);
    }
#ifdef EXP_NULLEPI
    if (IN(2)) {
        xcd_barrier(xbar);
        pg8::Gemm g{H, WT_IN, NROW, PW, D}; pg8::StaticOrder S; S.init(NROW, PW, G, bx);
        pg8::EpiNull E{};
        pg8::gemm_phase<pg8::EpiNull, pg8::StaticOrder, true, true>((LAS unsigned char*)lds + RING_OFF, g, S, E);
    }
#endif
    SEAM(2);
    STAMP(3);
    if (IN(3)) {
        PHASE_IDS
        static_assert(attn_body::ATTN_LDS_BYTES <= RING_BYTES, "attention LDS");
        const attn_body::AttnTensors AT{(const attn_body::bf16*)(ws + WS_QA), (const attn_body::bf16*)(ws + WS_KA), (const attn_body::bf16*)(ws + WS_VA), (attn_body::bf16*)(ws + WS_QA), a.in[11]};
        const attn_body::StaticOrder S(G, bx);
        const bool hfirst = ((bx >> 3) & 1) != 0;
#define HGRN_A_UNITS() do { __syncthreads(); v4u rg_[6]; if (bx < NHUNIT) hgrn_a_load(rg_, bx, (const bf16_t*)(ws + WS_QR), (const bf16_t*)(ws + WS_GF), (const bf16_t*)(ws + WS_GB), (const bf16_t*)(ws + WS_IV), tid); \
        for (int unit = bx; unit < NHUNIT; unit += G) \
            hgrn_a_unit(unit, unit + G < NHUNIT ? unit + G : -1, rg_, (const bf16_t*)(ws + WS_QR), (bf16_t*)(ws + WS_GF), (bf16_t*)(ws + WS_GB), (const bf16_t*)(ws + WS_IV), (bf16_t*)(ws + WS_ORF), (bf16_t*)(ws + WS_ORB), \
                        (bf16_t*)(ws + WS_UT), (float*)(ws + WS_DEC), (LAS unsigned char*)lds + RING_OFF, (LAS float*)(lds + ROPE_OFF), tid); } while (0)
#define TR_CHUNK(ci) do { if ((ci) < 3) { __syncthreads(); { const int gw = bx * NWAVES + wave, NGW = G * NWAVES; \
            LAS float* scr = (LAS float*)(lds + RING_OFF + wave * 16640); \
            constexpr int NIT = 3 * 32 * 128; \
            f32x4 va[16], vb2[16]; const int it0 = gw + 2 * (ci) * NGW, it1 = it0 + NGW; \
            const TrDesc da = tr_expert_desc(it0 < NIT ? it0 : 0, weg, weu, wed, WGU, WDN), db = tr_expert_desc(it1 < NIT ? it1 : 0, weg, weu, wed, WGU, WDN); \
            if (it0 < NIT) tr_load64(va, da, lane); if (it1 < NIT) tr_load64(vb2, db, lane); \
            if (it0 < NIT) tr_finish64(va, da, scr, lane); if (it1 < NIT) tr_finish64(vb2, db, scr, lane); \
        } __syncthreads(); } } while (0)
        if (hfirst) HGRN_A_UNITS();
        {
            struct TrSched {
                attn_body::StaticOrder S; bool first; const float *weg, *weu, *wed; bf16_t *WGU, *WDN; unsigned char* lds;
                __device__ __forceinline__ bool next(int i, attn_body::AttnUnit& u) const { return S.next(i, u); }
                __device__ __forceinline__ void chunk(int ci) const { const int tid_ = fresh_tid(), lane = tid_ & 63, wave = __builtin_amdgcn_readfirstlane(tid_ >> 6), bx = blockIdx.x, G = gridDim.x; TR_CHUNK(ci); }
                __device__ __forceinline__ void a_ready(const attn_body::AttnUnit& u) const { if (first) chunk((((u.bh & 7) << 4 | u.qb) >> 5)); }
                __device__ __forceinline__ void done(const attn_body::AttnUnit& u) const { if (!first) chunk((((u.bh & 7) << 4 | u.qb) >> 5)); }
            };
            const TrSched TS{S, hfirst, weg, weu, wed, WGU, WDN, lds};
            attn_body::attn_phase<TrSched>((char*)lds + RING_OFF, AT, TS);
        }
        STAMP(4);
        if (!hfirst) HGRN_A_UNITS();
#undef HGRN_A_UNITS
#undef TR_CHUNK
    }
    SEAM(3);
    STAMP(5);
    if (IN(4)) {
        PHASE_IDS
        const int vcu = (G % 8 == 0) ? (bx % 8) * (G / 8) + bx / 8 : bx;
        for (int gw = vcu * NWAVES + wave; gw < 64 * 32; gw += G * NWAVES) hgrn_scan(gw, (bf16_t*)(ws + WS_UT), (const float*)(ws + WS_DEC), lane);
    }
    SEAM(4);
    STAMP(6);
    if (IN(5)) {
        PHASE_IDS
        const int vcu = (G % 8 == 0) ? (bx % 8) * (G / 8) + bx / 8 : bx;
        __syncthreads();
        HcPre hp;
        if (vcu < NB * 4 * 64) hgrn_c_load(hp, vcu, (const bf16_t*)(ws + WS_GF), (const bf16_t*)(ws + WS_GB), (const bf16_t*)(ws + WS_ORF), (const bf16_t*)(ws + WS_ORB), (const bf16_t*)(ws + WS_UT), (const bf16_t*)(ws + WS_GR), tid);
        for (int uid = vcu; uid < NB * 4 * 64; uid += G)
            hgrn_c_unit(uid, uid + G < NB * 4 * 64 ? uid + G : -1, hp, (const bf16_t*)(ws + WS_GF), (const bf16_t*)(ws + WS_GB), (bf16_t*)(ws + WS_ORF), (const bf16_t*)(ws + WS_ORB), (const bf16_t*)(ws + WS_UT), (const bf16_t*)(ws + WS_GR), a.in[13],
                        (LAS unsigned char*)lds + RING_OFF, tid);
    }
    SEAM(5);
    STAMP(7);
    if (IN(6)) {
        PHASE_IDS
        pg8::Gemm g{(const bf16_t*)(ws + WS_QA), WT_OUT, NLAT, D, D, 512, 8, (long)(WS_ORF - WS_QA) - 8 * 128}; pg8::StaticOrder S; S.init(NLAT, D, G, bx);
        pg8::EpiOutproj E{mod, DL};
        pg8::gemm_phase<pg8::EpiOutproj, pg8::StaticOrder, true, true>((LAS unsigned char*)lds + RING_OFF, g, S, E);
    }
    SEAM(6);
    STAMP(8);
    LAS int* segt = (LAS int*)(lds + MISC_OFF); LAS int* tile_e = (LAS int*)(lds + MISC_OFF + 256); LAS int* cntl = (LAS int*)(lds + MISC_OFF + 2048);
    int* ctl = (int*)(ws + WS_CTL);
    float* ew = (float*)(ws + WS_RT); int* list = (int*)(ws + WS_LIST);
    bf16_t* H2 = (bf16_t*)(ws + WS_H2M); bf16_t* ACT2 = (bf16_t*)(ws + WS_ACT2); bf16_t* YS2 = (bf16_t*)(ws + WS_YS2);
    if (IN(7)) {
        PHASE_IDS
        const float* norm2_g = a.in[7]; const float* brg = a.in[16]; const float* bre = a.in[18];
        const bf16_t* WRT = (const bf16_t*)(ws + WS_WRT);
        constexpr int HT_LD = 1032;
        LAS bf16_t* HT = (LAS bf16_t*)(lds);
        LAS float* PART = (LAS float*)(lds + 34816);
        LAS float* LG = (LAS float*)(lds + 34816 + 24576);
        LAS int* lhist = (LAS int*)(lds + 65536); LAS int* lbase = lhist + 32; LAS int* asg = lhist + 64;
        const int ln = lane & 15, lg4 = lane >> 4;
        for (int wg0 = ((G % 8 == 0) ? (bx % 8) * (G / 8) + bx / 8 : bx); wg0 < NLAT / 128; wg0 += G) {
            const int tokw = wg0 * 128; const float* m = mod + (tokw / SEQ) * 6144;
            if (tid < 32) lhist[tid] = 0;
            f32x4 ga[4], sh[4];
#pragma unroll
            for (int j = 0; j < 4; ++j) { const int k = 4 * lane + 256 * j; const f32x4 g = *(const f32x4*)(norm2_g + k), sc = *(const f32x4*)(m + 4096 + k); sh[j] = *(const f32x4*)(m + 3072 + k); ga[j] = g * (1.f + sc); }
            bf16x8_t wf[4][3];
#pragma unroll
            for (int ks = 0; ks < 4; ++ks)
#pragma unroll
                for (int nt = 0; nt < 3; ++nt) wf[ks][nt] = *(const bf16x8_t*)(WRT + (size_t)(16 * nt + ln) * D + 128 * wave + 32 * ks + 8 * lg4);
            f32x4 xv[2][4]; uint2 dv[2][4];
#pragma unroll
            for (int r = 0; r < 2; ++r)
#pragma unroll
                for (int j = 0; j < 4; ++j) { const size_t o_ = (size_t)(tokw + 2 * wave + r) * D + 4 * lane + 256 * j; xv[r][j] = __builtin_nontemporal_load((const f32x4*)(x + o_)); dv[r][j] = *(const uint2*)(DL + o_); }
            for (int t = 0; t < 8; ++t) {
                const int tok0 = tokw + 16 * t;
#pragma unroll
                for (int r = 0; r < 2; ++r) {
                    f32x4 v[4]; float ss = 0.f;
#pragma unroll
                    for (int j = 0; j < 4; ++j) { v[j] = (f32x4){xv[r][j][0] + __uint_as_float(dv[r][j].x << 16), xv[r][j][1] + __uint_as_float(dv[r][j].x & 0xffff0000u), xv[r][j][2] + __uint_as_float(dv[r][j].y << 16), xv[r][j][3] + __uint_as_float(dv[r][j].y & 0xffff0000u)};
                        ss += (v[j][0] * v[j][0] + v[j][1] * v[j][1]) + (v[j][2] * v[j][2] + v[j][3] * v[j][3]); }
                    const float rstd = rsqrtf(wave_sum(ss) * (1.f / D) + EPS);
#pragma unroll
                    for (int j = 0; j < 4; ++j) { const f32x4 o = v[j] * rstd * ga[j] + sh[j]; uint2 pk; pk.x = pk2(o[0], o[1]); pk.y = pk2(o[2], o[3]);
                        *(uint2*)(H2 + (size_t)(tok0 + 2 * wave + r) * D + 4 * lane + 256 * j) = pk; *(LAS v2u*)(HT + (2 * wave + r) * HT_LD + 4 * lane + 256 * j) = (v2u){pk.x, pk.y}; }
                }
                LBAR();
                if (t + 1 < 8) {
#pragma unroll
                    for (int r = 0; r < 2; ++r)
#pragma unroll
                        for (int j = 0; j < 4; ++j) { const size_t o_ = (size_t)(tok0 + 16 + 2 * wave + r) * D + 4 * lane + 256 * j; xv[r][j] = __builtin_nontemporal_load((const f32x4*)(x + o_)); dv[r][j] = *(const uint2*)(DL + o_); }
                }
                f32x4 acc[3];
#pragma unroll
                for (int nt = 0; nt < 3; ++nt) acc[nt] = (f32x4){0.f, 0.f, 0.f, 0.f};
#pragma unroll
                for (int ks = 0; ks < 4; ++ks) {
                    const bf16x8_t af = *(const LAS bf16x8_t*)(HT + ln * HT_LD + 128 * wave + 32 * ks + 8 * lg4);
#pragma unroll
                    for (int nt = 0; nt < 3; ++nt) acc[nt] = __builtin_amdgcn_mfma_f32_16x16x32_bf16(af, wf[ks][nt], acc[nt], 0, 0, 0);
                }
#pragma unroll
                for (int nt = 0; nt < 3; ++nt)
#pragma unroll
                    for (int rg = 0; rg < 4; ++rg) PART[(wave * 16 + 4 * lg4 + rg) * 48 + 16 * nt + ln] = acc[nt][rg];
                LBAR();
                for (int p = tid; p < 16 * 36; p += NWAVES * 64) { const int row = p / 36, n = p % 36; float sacc = 0.f;
#pragma unroll
                    for (int w = 0; w < 8; ++w) sacc += PART[(w * 16 + row) * 48 + n];
                    LG[row * 48 + n] = sacc; }
                LBAR();
                if (tid < 16) {
                    const LAS float* l = LG + tid * 48; const int tok = tok0 + tid;
                    float lgp[4]; int gs = 0; float gm = -1e30f;
#pragma unroll
                    for (int g = 0; g < 4; ++g) { lgp[g] = l[g] + brg[g]; if (lgp[g] > gm) { gm = lgp[g]; gs = g; } }
                    float z = 0.f;
#pragma unroll
                    for (int g = 0; g < 4; ++g) z += __expf(lgp[g] - gm);
                    const float pg = 1.f / z;
                    int e1 = 0, e2 = 0; float m1 = -1e30f, m2 = -1e30f;
                    for (int j = 0; j < 8; ++j) { const float v = l[4 + gs * 8 + j] + bre[gs * 8 + j]; if (v > m1) { m2 = m1; e2 = e1; m1 = v; e1 = j; } else if (v > m2) { m2 = v; e2 = j; } }
                    const float rr = __expf(m2 - m1);
                    const int E1 = gs * 8 + e1, E2 = gs * 8 + e2;
                    ew[tok * 2] = pg / (1.f + rr); ew[tok * 2 + 1] = pg * rr / (1.f + rr);
                    const int r1 = __hip_atomic_fetch_add(lhist + E1, 1, __ATOMIC_RELAXED, __HIP_MEMORY_SCOPE_WORKGROUP), r2 = __hip_atomic_fetch_add(lhist + E2, 1, __ATOMIC_RELAXED, __HIP_MEMORY_SCOPE_WORKGROUP);
                    asg[(16 * t + tid) * 2] = (E1 << 16) | r1; asg[(16 * t + tid) * 2 + 1] = (E2 << 16) | r2;
                }
            }
            LBAR();
            if (tid < 32) { const int n = lhist[tid]; lbase[tid] = n ? atomicAdd(&ctl[CW_CNT + 64 * tid], n) : 0; }
            LBAR();
            if (tid < 256) { const int e_ = asg[tid] >> 16, r_ = asg[tid] & 0xffff; list[e_ * LISTCAP + lbase[e_] + r_] = (tokw + (tid >> 1)) * 2 + (tid & 1); }
            LBAR();
        }
    }
    SEAM(7);
    STAMP(9);
    STAMP(10);
    if (IN(9)) {
        PHASE_IDS
        const int ntl = build_tiles(ctl, segt, tile_e, cntl, tid);
        LAS int* rowtab = (LAS int*)(lds + ROPE_OFF);
        const int cu = (G % 8 == 0) ? (bx % 8) * (G / 8) + bx / 8 : bx;
        for (int i = 0; i * G + cu < ntl * 4 && i < 8; ++i) {
            const int ti = (i * G + cu) >> 2, e = tile_e[ti], r0 = (ti - segt[e]) * 256;
            if (tid < 256) rowtab[i * 256 + tid] = (r0 + tid < cntl[e]) ? (list[e * LISTCAP + r0 + tid] >> 1) : 0;
        }
        __syncthreads();
        pg8::Gemm g{H2, WGU, 0, 0, D}; pg8::GroupSchedT<true> S{tile_e, ntl * 4, G, cu, (size_t)1024 * 1024 * 2, rowtab};
        pg8::EpiMoe1 E{ACT2};
        pg8::gemm_phase<pg8::EpiMoe1, pg8::GroupSchedT<true>, true, true>((LAS unsigned char*)lds + RING_OFF, g, S, E);
    }
    SEAM(9);
    STAMP(11);
    if (IN(10)) {
        PHASE_IDS
        const int ntl = build_tiles(ctl, segt, tile_e, cntl, tid);
        const int cu = (G % 8 == 0) ? (bx % 8) * (G / 8) + bx / 8 : bx;
        pg8::Gemm g{ACT2, WDN, 0, 0, FFE}; pg8::GroupSchedT<false> S{tile_e, ntl * 4, G, cu, (size_t)1024 * 512 * 2, nullptr};
        LAS int* ridx = (LAS int*)(lds + XTRA_OFF); LAS float* rw = (LAS float*)(lds + XTRA_OFF + 8192);
        for (int i = 0; i * G + cu < ntl * 4 && i < 8; ++i) {
            const int ti = (i * G + cu) >> 2, e = tile_e[ti], r0 = (ti - segt[e]) * 256;
            if (tid < 256) { const bool ok = r0 + tid < cntl[e]; const int idx = ok ? list[e * LISTCAP + r0 + tid] : -1; ridx[i * 256 + tid] = idx; rw[i * 256 + tid] = ok ? ew[idx] : 0.f; }
        }
        __syncthreads();
        pg8::EpiMoe2 E{YS2, ridx, rw, G, cu};
        pg8::gemm_phase<pg8::EpiMoe2, pg8::GroupSchedT<false>, true, true>((LAS unsigned char*)lds + RING_OFF, g, S, E);
    }
    SEAM(10);
    STAMP(12);
    if (IN(11)) {
        PHASE_IDS
        const int gw = bx * NWAVES + wave, NGW = G * NWAVES;
        const unsigned char* YS8 = (const unsigned char*)YS2;
        for (int grp = gw; grp < NLAT / 2; grp += NGW) {
            const float* m = mod + ((2 * grp) / SEQ) * 6144 + 5120 + 16 * lane;
            f32x4 xv[2][4], gt[4]; v4u dv[2][2], p[2], q[2];
#pragma unroll
            for (int r = 0; r < 2; ++r) { const size_t tok = 2 * grp + r;
#pragma unroll
                for (int j = 0; j < 4; ++j) xv[r][j] = *(const f32x4*)(x + tok * D + 16 * lane + 4 * j);
                dv[r][0] = *(const v4u*)(DL + tok * D + 16 * lane); dv[r][1] = *(const v4u*)(DL + tok * D + 16 * lane + 8);
                p[r] = *(const v4u*)(YS8 + (2 * tok) * D + 16 * lane); q[r] = *(const v4u*)(YS8 + (2 * tok + 1) * D + 16 * lane); }
#pragma unroll
            for (int j = 0; j < 4; ++j) gt[j] = *(const f32x4*)(m + 4 * j);
#pragma unroll
            for (int r = 0; r < 2; ++r) {
                const unsigned pw[4] = {p[r].x, p[r].y, p[r].z, p[r].w}, qw[4] = {q[r].x, q[r].y, q[r].z, q[r].w};
                const unsigned dw[8] = {dv[r][0].x, dv[r][0].y, dv[r][0].z, dv[r][0].w, dv[r][1].x, dv[r][1].y, dv[r][1].z, dv[r][1].w};
#pragma unroll
                for (int j = 0; j < 4; ++j) {
                    float y0[4], y1[4]; unpack4_fp8(pw[j], y0); unpack4_fp8(qw[j], y1);
                    f32x4 o;
                    o[0] = xv[r][j][0] + __uint_as_float(dw[2 * j] << 16) + gt[j][0] * (y0[0] + y1[0]);
                    o[1] = xv[r][j][1] + __uint_as_float(dw[2 * j] & 0xffff0000u) + gt[j][1] * (y0[1] + y1[1]);
                    o[2] = xv[r][j][2] + __uint_as_float(dw[2 * j + 1] << 16) + gt[j][2] * (y0[2] + y1[2]);
                    o[3] = xv[r][j][3] + __uint_as_float(dw[2 * j + 1] & 0xffff0000u) + gt[j][3] * (y0[3] + y1[3]);
                    *(f32x4*)(a.out + (size_t)(2 * grp + r) * D + 16 * lane + 4 * j) = o;
                }
            }
        }
    }
    STAMP(13);
    if (TIME_A >= 0 && bx == 0 && tid == 0) {
        volatile LAS unsigned long long* tsl = (volatile LAS unsigned long long*)(lds + MISC_OFF + 4608);
        const unsigned long long dl = (tsl[TIME_B] - tsl[TIME_A]) * 4ull, t0 = __builtin_amdgcn_s_memrealtime();
        while (__builtin_amdgcn_s_memrealtime() - t0 < dl) __builtin_amdgcn_s_sleep(8);
    }
#undef IN
#undef SEAM
}
extern "C" void kernel_launch(void* const* d_in, const int* in_sizes, int n_in, void* d_out, int out_size, void* d_ws, size_t ws_size, hipStream_t stream) {
    static int grid = 0;
    if (grid == 0) {
        if (n_in != 22 || ws_size < WS_END) { fprintf(stderr, "kernel_launch: unexpected n_in %d / ws_size %zu\n", n_in, ws_size); grid = -1; return; }
        int dev = 0, cus = 0, per_cu = 0;
        if (hipGetDevice(&dev) != hipSuccess || hipDeviceGetAttribute(&cus, hipDeviceAttributeMultiprocessorCount, dev) != hipSuccess) { grid = -1; return; }
        if (hipFuncSetAttribute((const void*)mk_fwd, hipFuncAttributeMaxDynamicSharedMemorySize, LDS_BYTES) != hipSuccess) { fprintf(stderr, "kernel_launch: hipFuncSetAttribute failed\n"); grid = -1; return; }
        if (hipOccupancyMaxActiveBlocksPerMultiprocessor(&per_cu, (const void*)mk_fwd, NWAVES * 64, LDS_BYTES) != hipSuccess || per_cu < 1) { fprintf(stderr, "kernel_launch: occupancy query says %d\n", per_cu); per_cu = 1; }
        (void)hipGetLastError();
        grid = cus;
        fprintf(stderr, "kernel_launch: cus %d per_cu %d grid %d\n", cus, per_cu, grid);
    }
    if (grid < 0) return;
    float* out = (float*)d_out;
    unsigned char* ws = (unsigned char*)d_ws;
    int* ctl = (int*)(ws + WS_CTL);
    (void)hipMemsetAsync(ctl, 0, 64 * 1024, stream);
    Args a{};
    for (int i = 0; i < 22; ++i) a.in[i] = (const float*)d_in[i];
    a.out = out; a.ws = ws;
    void* kargs[] = {&a};
    a.ph_lo = 0; a.ph_hi = 12;
    hipError_t le = hipLaunchCooperativeKernel((const void*)mk_fwd, dim3(grid), dim3(NWAVES * 64), kargs, LDS_BYTES, stream);
    if (le != hipSuccess) fprintf(stderr, "kernel_launch: cooperative launch failed: %s\n", hipGetErrorString(le));
}
```

```cpp
#include <hip/hip_runtime.h>
#include <hip/hip_cooperative_groups.h>
#include <cstdio>
#include <cstdint>
namespace cg = cooperative_groups;

typedef unsigned short bf16_t;
__device__ __forceinline__ float bf2f(bf16_t v) { return __uint_as_float(((unsigned)v) << 16); }
typedef float f32x2_c __attribute__((ext_vector_type(2))); typedef __bf16 bf16x2_c __attribute__((ext_vector_type(2)));
__device__ __forceinline__ unsigned pk2(float lo, float hi) { f32x2_c v = {lo, hi}; bf16x2_c b = __builtin_convertvector(v, bf16x2_c); return __builtin_bit_cast(unsigned, b); }
__device__ __forceinline__ bf16_t f2bf(float f) { return (bf16_t)(pk2(f, 0.f) & 0xffffu); }

constexpr int D = 1024, NB = 8, SEQ = 4096, CTX = 256, TPB = SEQ + CTX;
constexpr int NROW = NB * TPB;
constexpr int NLAT = NB * SEQ;
constexpr int PW = 3328;
constexpr int NEXP = 32, FFE = 512;
constexpr float EPS = 1e-6f;
constexpr int LISTCAP = NLAT;
constexpr int MAXTILES = 65536 / 64 + 32;
constexpr float C2 = 0.125f * 1.4426950408889634f;

constexpr size_t MiB = 1ull << 20;
constexpr size_t WS_CTL = 0;
constexpr size_t WS_MOD = 1 * MiB;
constexpr size_t WS_WRT = 1 * MiB + 512 * 1024;
constexpr size_t WS_WTIN = 2 * MiB;
constexpr size_t WS_WTOUT = 9 * MiB;
constexpr size_t WS_UT = 11 * MiB;
constexpr size_t WS_DEC = 147 * MiB;
constexpr size_t WS_H = 107 * MiB;
constexpr size_t WS_QA = 175 * MiB;
constexpr size_t WS_KA = 207 * MiB;
constexpr size_t WS_VA = 216 * MiB;
constexpr size_t WS_QR = 225 * MiB;
constexpr size_t WS_GF = 259 * MiB;
constexpr size_t WS_GB = 293 * MiB;
constexpr size_t WS_IV = 327 * MiB;
constexpr size_t WS_GR = 361 * MiB;
constexpr size_t WS_ORF = 393 * MiB, WS_ORB = 425 * MiB;
constexpr size_t WS_RT = 489 * MiB;
constexpr size_t WS_LIST = WS_RT + 256 * 1024;
constexpr size_t WS_END = 494 * MiB;
constexpr size_t WS_MIXIN = 11 * MiB;
constexpr size_t WS_H2M = 107 * MiB;
constexpr size_t WS_H2S = 175 * MiB;
constexpr size_t WS_ACT2 = 11 * MiB;
constexpr size_t WS_DL = 225 * MiB;
constexpr size_t OUT_WGU = 0, OUT_WDN = 64 * MiB;
constexpr size_t WS_YS2 = 361 * MiB;
constexpr int MAXT256 = 65536 / 256 + 32;
constexpr int NCHUNK = TPB / 64;
constexpr int NHUNIT = NB * 4 * 2 * NCHUNK;

constexpr int CT_CNT = 0, CT_NT = 32, CT_TE = 64, CT_TI = CT_TE + MAXTILES, CT_TS = CT_TI + MAXTILES;

__device__ __forceinline__ float wave_sum(float v) {
#pragma unroll
    for (int o = 32; o >= 1; o >>= 1) v += __shfl_xor(v, o);
    return v;
}
__device__ __forceinline__ float half_sum(float v) {
#pragma unroll
    for (int o = 16; o >= 1; o >>= 1) v += __shfl_xor(v, o);
    return v;
}

constexpr float FP8_SC = 32.f, FP8_ISC = 1.f / 32.f;
__device__ __forceinline__ unsigned pack4_fp8(float a, float b, float c, float d) {
    a = fminf(fmaxf(a * FP8_SC, -448.f), 448.f); b = fminf(fmaxf(b * FP8_SC, -448.f), 448.f); c = fminf(fmaxf(c * FP8_SC, -448.f), 448.f); d = fminf(fmaxf(d * FP8_SC, -448.f), 448.f);
    int w = __builtin_amdgcn_cvt_pk_fp8_f32(a, b, 0, false); w = __builtin_amdgcn_cvt_pk_fp8_f32(c, d, w, true); return (unsigned)w;
}
typedef float f32x2_u __attribute__((ext_vector_type(2)));
__device__ __forceinline__ void unpack4_fp8(unsigned w, float (&o)[4]) {
    const f32x2_u lo = __builtin_amdgcn_cvt_pk_f32_fp8((int)w, false), hi = __builtin_amdgcn_cvt_pk_f32_fp8((int)w, true);
    o[0] = lo.x * FP8_ISC; o[1] = lo.y * FP8_ISC; o[2] = hi.x * FP8_ISC; o[3] = hi.y * FP8_ISC;
}
namespace pg8 {
#define PG8_LAS __attribute__((address_space(3)))
typedef unsigned short bf16_t;
typedef short bf16x8 __attribute__((ext_vector_type(8)));
typedef float f32x4 __attribute__((ext_vector_type(4)));
typedef unsigned u32x4 __attribute__((ext_vector_type(4)));
constexpr int BM = 256, BK = 64, HALF = 128, HTB = HALF * BK * 2  , STAGE_BYTES = 8 * HTB, NXCD = 8, WGM = 8;

__host__ __device__ __forceinline__ int lds_byte(int r, int c) { const int st = (r >> 4) * 2 + (c >> 5), rr = r & 15, cc = c & 31, ob = rr * 64 + cc * 2; return st * 1024 + (ob ^ (((ob >> 9) & 1) << 5)); }
__host__ __device__ __forceinline__ void stage_rc(int b, int& R, int& C) { const int st = b / 1024, sb = b % 1024, swz = sb ^ (((sb >> 9) & 1) << 5); R = (st >> 1) * 16 + swz / 64; C = (st & 1) * 32 + (swz % 64) / 2; }
__host__ __device__ __forceinline__ int perm32(int rho) { const int n = rho >> 4, i = rho & 15; return 8 * (i >> 2) + 4 * n + (i & 3); }

struct Unit { int pm, pn, ord; };
struct Gemm { const bf16_t* A; const bf16_t* Bt; int M, N, K; int lda = 0; int nsplit = 1 << 30; long adelta = 0; };

struct StaticOrder {
    static constexpr bool GATHER = false;
    __device__ __forceinline__ int arow(int, int) const { return 0; }
    int nM, nN, nwg, G, c;
    __host__ __device__ void init(int M, int N, int G_, int c_) { nM = M / BM; nN = N / BM; nwg = nM * nN; G = G_; c = c_; }
    __host__ __device__ bool next(int i, Unit& u) const {
        const long L = (long)i * G + c; if (L >= nwg) return false;
        int wgid = (int)L; { const int q = nwg / NXCD, r = nwg % NXCD, xcd = wgid % NXCD, off = wgid / NXCD; wgid = (xcd < r ? xcd * (q + 1) : r * (q + 1) + (xcd - r) * q) + off; }
        const int nig = WGM * nN, gid = wgid / nig, fm = gid * WGM, gsz = (nM - fm) < WGM ? (nM - fm) : WGM;
        u.pm = fm + ((wgid % nig) % gsz); u.pn = (wgid % nig) / gsz; u.ord = i; return true;
    }
    __device__ __forceinline__ const char* aptr(const Gemm& g, const Unit& u, size_t tstep) const { return (const char*)g.A + (size_t)u.pm * tstep; }
    __device__ __forceinline__ const char* bptr(const Gemm& g, const Unit& u, size_t tstep) const { return (const char*)g.Bt + (size_t)u.pn * tstep; }
    __device__ __forceinline__ void a_ready(const Unit&) const {}
    __device__ __forceinline__ void done(const Unit&) const {}
};
__device__ __forceinline__ unsigned cvt_pk_bf16(float lo, float hi) { unsigned r; asm volatile("v_cvt_pk_bf16_f32 %0, %1, %2" : "=v"(r) : "v"(lo), "v"(hi)); return r; }
typedef float f32x2 __attribute__((ext_vector_type(2)));
typedef unsigned u32x2 __attribute__((ext_vector_type(2)));
__device__ __forceinline__ float fsigmoid(float x) { return __builtin_amdgcn_rcpf(1.f + __expf(-x)); }

struct EpiInproj {
    static constexpr bool PERM = true, AFTER_DRAIN = false;
    bf16_t *QA, *KA, *VA, *QR, *GF, *GB, *IV, *GR; const PG8_LAS float *qg, *kg, *lb; const PG8_LAS f32x2* rope;
    __device__ __forceinline__ void operator()(const f32x4 (&acc)[2][2][4][2], const Unit& u, int wr, int wc, int fr, int fq) const {
        const int pn = u.pn, pmb = u.pm / 17, pmr = u.pm % 17;
        const bool isctx = (pmr == 0);
        if (pn <= 2) {
            const bool isV = (pn == 2) && (wc >= 2);
            if (pn < 2 && isctx) return;
            float gv[2][2][4];
            const PG8_LAS float* gsrc = pn < 2 ? qg : kg;
#pragma unroll
            for (int bj = 0; bj < 2; ++bj)
#pragma unroll
                for (int n = 0; n < 2; ++n) { const f32x4 t = *(const PG8_LAS f32x4*)(gsrc + 32 * bj + 8 * fq + 4 * n); gv[bj][n][0] = t[0]; gv[bj][n][1] = t[1]; gv[bj][n][2] = t[2]; gv[bj][n][3] = t[3]; }
            const float osc = pn < 2 ? C2 : 1.0f;
#pragma unroll
            for (int ai = 0; ai < 2; ++ai)
#pragma unroll
                for (int m = 0; m < 4; ++m) {
                    const int rl = 128 * ai + 64 * wr + 16 * m + fr;
                    const size_t grow = (size_t)u.pm * 256 + rl;
                    f32x4 v[2][2];
#pragma unroll
                    for (int bj = 0; bj < 2; ++bj)
#pragma unroll
                        for (int n = 0; n < 2; ++n) v[bj][n] = acc[ai][bj][m][n];
                    if (!isV) {
                        float ss = 0.f;
#pragma unroll
                        for (int bj = 0; bj < 2; ++bj)
#pragma unroll
                            for (int n = 0; n < 2; ++n) ss += (v[bj][n][0] * v[bj][n][0] + v[bj][n][1] * v[bj][n][1]) + (v[bj][n][2] * v[bj][n][2] + v[bj][n][3] * v[bj][n][3]);
                        ss += __shfl_xor(ss, 16); ss += __shfl_xor(ss, 32);
                        const float rstd = rsqrtf(ss * (1.f / 64.f) + EPS) * osc;
                        const int ri = 4 * (pmr - 1) + 2 * ai + wr, ci = 16 * m + fr;
#pragma unroll
                        for (int bj = 0; bj < 2; ++bj) {
                            const int posv = bj ? ci : ri;
#pragma unroll
                            for (int n = 0; n < 2; ++n)
#pragma unroll
                                for (int p = 0; p < 2; ++p) {
                                    f32x2 cs = (f32x2){1.f, 0.f};
                                    if (!isctx) cs = rope[posv * 16 + 4 * fq + 2 * n + p];
                                    const float x1 = v[bj][n][2 * p] * rstd * gv[bj][n][2 * p], x2 = v[bj][n][2 * p + 1] * rstd * gv[bj][n][2 * p + 1];
                                    v[bj][n][2 * p] = x1 * cs.x - x2 * cs.y; v[bj][n][2 * p + 1] = x1 * cs.y + x2 * cs.x;
                                }
                        }
                    }
                    bf16_t* dst;
                    if (pn < 2) dst = QA + ((size_t)pmb * SEQ + (size_t)(pmr - 1) * 256 + rl) * 512 + (4 * pn + wc) * 64 + 8 * fq;
                    else if (!isV) dst = KA + grow * 128 + wc * 64 + 8 * fq;
                    else dst = VA + grow * 128 + (wc - 2) * 64 + 8 * fq;
#pragma unroll
                    for (int bj = 0; bj < 2; ++bj) {
                        u32x4 w; w.x = cvt_pk_bf16(v[bj][0][0], v[bj][0][1]); w.y = cvt_pk_bf16(v[bj][0][2], v[bj][0][3]); w.z = cvt_pk_bf16(v[bj][1][0], v[bj][1][1]); w.w = cvt_pk_bf16(v[bj][1][2], v[bj][1][3]);
                        *(u32x4*)(dst + 32 * bj) = w;
                    }
                }
            return;
        }
        const int seg = pn <= 4 ? 0 : (pn <= 8 ? 1 : (pn <= 10 ? 2 : 3));
        if (seg == 3 && isctx) return;
        int cb; bf16_t* base; int dir = 0;
        if (seg == 0) { cb = 256 * (pn - 3); base = QR; }
        else if (seg == 1) { dir = (pn - 5) >> 1; cb = 256 * ((pn - 5) & 1); base = dir ? GB : GF; }
        else if (seg == 2) { cb = 256 * (pn - 9); base = IV; }
        else { cb = 256 * (pn - 11); base = GR; }
        const int c0 = cb + 32 * wc + 8 * fq;
        f32x4 lbv[2][2];
        if (seg == 1) {
#pragma unroll
            for (int bj = 0; bj < 2; ++bj)
#pragma unroll
                for (int n = 0; n < 2; ++n) lbv[bj][n] = *(const PG8_LAS f32x4*)(lb + dir * 512 + c0 + 128 * bj + 4 * n);
        }
#pragma unroll
        for (int ai = 0; ai < 2; ++ai)
#pragma unroll
            for (int m = 0; m < 4; ++m) {
                const int rl = 128 * ai + 64 * wr + 16 * m + fr;
                const size_t drow = seg == 3 ? ((size_t)pmb * SEQ + (size_t)(pmr - 1) * 256 + rl) : ((size_t)u.pm * 256 + rl);
                bf16_t* dst = base + drow * 512 + c0;
#pragma unroll
                for (int bj = 0; bj < 2; ++bj) {
                    f32x4 v0 = acc[ai][bj][m][0], v1 = acc[ai][bj][m][1];
                    if (seg == 0) {
#pragma unroll
                        for (int i = 0; i < 4; ++i) { v0[i] = v0[i] * fsigmoid(v0[i]) * 0.08838834764831845f; v1[i] = v1[i] * fsigmoid(v1[i]) * 0.08838834764831845f; }
                    } else if (seg == 1) {
#pragma unroll
                        for (int i = 0; i < 4; ++i) { const float l0 = lbv[bj][0][i], l1 = lbv[bj][1][i]; v0[i] = __logf(l0 + (1.f - l0) * fsigmoid(v0[i])); v1[i] = __logf(l1 + (1.f - l1) * fsigmoid(v1[i])); }
                    } else if (seg == 3) {
#pragma unroll
                        for (int i = 0; i < 4; ++i) { v0[i] = v0[i] * fsigmoid(v0[i]); v1[i] = v1[i] * fsigmoid(v1[i]); }
                    }
                    u32x4 w; w.x = cvt_pk_bf16(v0[0], v0[1]); w.y = cvt_pk_bf16(v0[2], v0[3]); w.z = cvt_pk_bf16(v1[0], v1[1]); w.w = cvt_pk_bf16(v1[2], v1[3]);
                    *(u32x4*)(dst + 128 * bj) = w;
                }
            }
    }
};

struct EpiOutproj {
    static constexpr bool PERM = true, AFTER_DRAIN = false;
    const float* mod; bf16_t* DL;
    __device__ __forceinline__ void operator()(const f32x4 (&acc)[2][2][4][2], const Unit& u, int wr, int wc, int fr, int fq) const {
        const float* gt = mod + (u.pm >> 4) * 6144 + 2048;
        const int row0 = u.pm * BM + wr * 64 + fr, col0 = u.pn * BM + wc * 32 + 8 * fq;
        f32x4 gv[2][2];
#pragma unroll
        for (int bj = 0; bj < 2; ++bj)
#pragma unroll
            for (int n = 0; n < 2; ++n) gv[bj][n] = *(const f32x4*)(gt + col0 + bj * HALF + 4 * n);
#pragma unroll
        for (int ai = 0; ai < 2; ++ai)
#pragma unroll
            for (int m = 0; m < 4; ++m) { bf16_t* dst = DL + (size_t)(row0 + ai * HALF + m * 16) * 1024 + col0;
#pragma unroll
                for (int bj = 0; bj < 2; ++bj) { const f32x4 v0 = gv[bj][0] * acc[ai][bj][m][0], v1 = gv[bj][1] * acc[ai][bj][m][1];
                    u32x4 w; w.x = cvt_pk_bf16(v0[0], v0[1]); w.y = cvt_pk_bf16(v0[2], v0[3]); w.z = cvt_pk_bf16(v1[0], v1[1]); w.w = cvt_pk_bf16(v1[2], v1[3]);
                    *(u32x4*)(dst + bj * HALF) = w; } }
    }
};

template <bool GATHER_> struct GroupSchedT {
    static constexpr bool GATHER = GATHER_;
    const PG8_LAS int* tile_e; int nunits, G, c; size_t estride;
    const PG8_LAS int* rowtab;
    __device__ __forceinline__ int arow(int i, int r) const { return rowtab[i * 256 + r]; }
    __device__ __forceinline__ bool next(int i, Unit& u) const { const int L = i * G + c; if (L >= nunits) return false; u.pm = L >> 2; u.pn = L & 3; u.ord = i; return true; }
    __device__ __forceinline__ const char* aptr(const Gemm& g, const Unit& u, size_t tstep) const { return GATHER ? (const char*)g.A : (const char*)g.A + (size_t)u.pm * tstep; }
    __device__ __forceinline__ const char* bptr(const Gemm& g, const Unit& u, size_t tstep) const { return (const char*)g.Bt + (size_t)tile_e[u.pm] * estride + (size_t)u.pn * tstep; }
    __device__ __forceinline__ void a_ready(const Unit&) const {}
    __device__ __forceinline__ void done(const Unit&) const {}
};
constexpr int FLOW_FS = 16;
struct MoeProdSched {
    static constexpr bool GATHER = true;
    const PG8_LAS int* tile_e; int nunits, G, c; size_t estride; const PG8_LAS int* rowtab; unsigned* flags;
    __device__ __forceinline__ int arow(int i, int r) const { return rowtab[i * 256 + r]; }
    __device__ __forceinline__ bool next(int i, Unit& u) const { const int L = i * G + c; if (L >= nunits) return false; u.pm = L >> 2; u.pn = L & 3; u.ord = i; return true; }
    __device__ __forceinline__ const char* aptr(const Gemm& g, const Unit&, size_t) const { return (const char*)g.A; }
    __device__ __forceinline__ const char* bptr(const Gemm& g, const Unit& u, size_t tstep) const { return (const char*)g.Bt + (size_t)tile_e[u.pm] * estride + (size_t)u.pn * tstep; }
    __device__ __forceinline__ void a_ready(const Unit&) const {}
    __device__ __forceinline__ void done(const Unit& u) const {
        asm volatile("s_waitcnt vmcnt(0)" ::: "memory");
        __builtin_amdgcn_s_barrier();
        if (threadIdx.x == 0) (void)__hip_atomic_fetch_add(flags + FLOW_FS * u.pm, 1u, __ATOMIC_RELAXED, __HIP_MEMORY_SCOPE_AGENT);
    }
};
struct MoeConsSched {
    static constexpr bool GATHER = false;
    const PG8_LAS int* tile_e; int nunits, G, c, n5; size_t estride; unsigned* flags;
    __device__ __forceinline__ int arow(int, int) const { return 0; }
    __device__ __forceinline__ int q_of(int i) const { const int ns = G - n5; if (c >= n5) { const int p = c - n5; return i == 0 ? p : ns + (i - 1) * G + p; } return ns + i * G + ns + c; }
    __device__ __forceinline__ bool next(int i, Unit& u) const { const int q = q_of(i); if (q >= nunits) return false; u.pm = q >> 2; u.pn = q & 3; u.ord = i; return true; }
    __device__ __forceinline__ const char* aptr(const Gemm& g, const Unit& u, size_t tstep) const { return (const char*)g.A + (size_t)u.pm * tstep; }
    __device__ __forceinline__ const char* bptr(const Gemm& g, const Unit& u, size_t tstep) const { return (const char*)g.Bt + (size_t)tile_e[u.pm] * estride + (size_t)u.pn * tstep; }
    __device__ __forceinline__ void wait_tile(int pm) const {
        unsigned* f = flags + FLOW_FS * pm; unsigned sp = 0;
        while (__hip_atomic_load(f, __ATOMIC_RELAXED, __HIP_MEMORY_SCOPE_AGENT) < 4u) { __builtin_amdgcn_s_sleep(2); if (++sp > (1u << 20)) break; }
        asm volatile("buffer_inv sc1" ::: "memory");
    }
    __device__ __forceinline__ void a_ready(const Unit& u) const { if (u.ord == 0) return; if (__builtin_amdgcn_readfirstlane(threadIdx.x >> 6) == 0) wait_tile(u.pm); }
    __device__ __forceinline__ void done(const Unit&) const {}
};
struct EpiMoe1 {
    static constexpr bool PERM = true, AFTER_DRAIN = false;
    bf16_t* ACT;
    __device__ __forceinline__ void operator()(const f32x4 (&acc)[2][2][4][2], const Unit& u, int wr, int wc, int fr, int fq) const {
        const int f0 = 128 * u.pn + 32 * wc + 8 * fq;
#pragma unroll
        for (int ai = 0; ai < 2; ++ai)
#pragma unroll
            for (int m = 0; m < 4; ++m) {
                const size_t slot = (size_t)u.pm * 256 + 128 * ai + 64 * wr + 16 * m + fr;
                f32x4 v0, v1;
#pragma unroll
                for (int i = 0; i < 4; ++i) { const float g0 = acc[ai][0][m][0][i], g1 = acc[ai][0][m][1][i]; v0[i] = g0 * fsigmoid(g0) * acc[ai][1][m][0][i]; v1[i] = g1 * fsigmoid(g1) * acc[ai][1][m][1][i]; }
                u32x4 w; w.x = cvt_pk_bf16(v0[0], v0[1]); w.y = cvt_pk_bf16(v0[2], v0[3]); w.z = cvt_pk_bf16(v1[0], v1[1]); w.w = cvt_pk_bf16(v1[2], v1[3]);
                asm volatile("global_store_dwordx4 %0, %1, off sc1" :: "v"(ACT + slot * 512 + f0), "v"(w) : "memory");
            }
    }
};
struct EpiMoe2 {
    static constexpr bool PERM = true, AFTER_DRAIN = false;
    bf16_t* YS; const PG8_LAS int* ridx; const PG8_LAS float* rw;
    __device__ __forceinline__ void operator()(const f32x4 (&acc)[2][2][4][2], const Unit& u, int wr, int wc, int fr, int fq) const {
        const int uo = u.ord;
        const int c0 = 256 * u.pn + 32 * wc + 8 * fq;
        int idxs[2][4]; float ws_[2][4];
#pragma unroll
        for (int ai = 0; ai < 2; ++ai)
#pragma unroll
            for (int m = 0; m < 4; ++m) { const int rl = 128 * ai + 64 * wr + 16 * m + fr; idxs[ai][m] = ridx[uo * 256 + rl]; ws_[ai][m] = rw[uo * 256 + rl]; }
#pragma unroll
        for (int ai = 0; ai < 2; ++ai)
#pragma unroll
            for (int m = 0; m < 4; ++m) {
                if (idxs[ai][m] >= 0) {
                    const int idx = idxs[ai][m]; const float w = ws_[ai][m];
                    unsigned char* dst = (unsigned char*)YS + (size_t)idx * 1024 + c0;
#pragma unroll
                    for (int bj = 0; bj < 2; ++bj) {
                        const f32x4 v0 = acc[ai][bj][m][0] * w, v1 = acc[ai][bj][m][1] * w;
                        u32x2 o; o.x = pack4_fp8(v0[0], v0[1], v0[2], v0[3]); o.y = pack4_fp8(v1[0], v1[1], v1[2], v1[3]);
                        *(u32x2*)(dst + 128 * bj) = o;
                    }
                }
            }
    }
};

struct EpiNull {
    static constexpr bool PERM = true, AFTER_DRAIN = false;
    __device__ __forceinline__ void operator()(const f32x4 (&acc)[2][2][4][2], const Unit&, int, int, int, int) const {
#pragma unroll
        for (int a = 0; a < 2; ++a)
#pragma unroll
            for (int b = 0; b < 2; ++b)
#pragma unroll
                for (int m = 0; m < 4; ++m)
#pragma unroll
                    for (int n = 0; n < 2; ++n) asm volatile("" :: "v"(acc[a][b][m][n]));
    }
};
template <class Epi, class Sched, bool ALIGN_EPI = false, bool SP2 = false>
__device__ __forceinline__ void gemm_phase(PG8_LAS unsigned char* lds, const Gemm g, const Sched& S, const Epi& E) {
    const int tid = threadIdx.x, wid = __builtin_amdgcn_readfirstlane(tid >> 6), lane = tid & 63, wr = wid >> 2, wc = wid & 3, fr = lane & 15, fq = lane >> 4;
    const int K = g.K, nt = K / BK, lda = g.lda ? g.lda : K, nsplit = g.nsplit; const long adelta = g.adelta;
    unsigned voffA[2], voffB[2];
#pragma unroll
    for (int i = 0; i < 2; ++i) { int R, C; stage_rc(tid * 16 + i * 8192, R, C); const int Rb = Epi::PERM ? ((R & ~31) + perm32(R & 31)) : R;
        voffA[i] = (unsigned)(R * lda + C) * 2u; voffB[i] = (unsigned)(Rb * K + C) * 2u; }
    constexpr bool GATHER = Sched::GATHER;
    static_assert(!GATHER || SP2, "gather staging is written for the SP2 loop");
    unsigned gA[2][2], gN[2][2], oN0[2], oN1[2]; int gR[2], gC[2];
    if constexpr (GATHER) {
#pragma unroll
        for (int i = 0; i < 2; ++i) { int R, C; stage_rc(tid * 16 + i * 8192, R, C); gR[i] = R; gC[i] = C * 2; }
#pragma unroll
        for (int h = 0; h < 2; ++h)
#pragma unroll
            for (int i = 0; i < 2; ++i) { gA[h][i] = (unsigned)S.arow(0, h * HALF + gR[i]) * (unsigned)(K * 2) + (unsigned)gC[i]; gN[h][i] = gA[h][i]; oN0[i] = gA[0][i]; oN1[i] = gA[1][i]; }
    }
#define PG8_STAGE_A(bufoff, ptr, half, nx) do { if constexpr (GATHER) { PG8_STAGE(bufoff, ptr, ((nx) ? ((half) ? oN1 : oN0) : gA[half])); } else { PG8_STAGE(bufoff, (ptr) + ((half) ? hstepA : (size_t)0), voffA); } } while (0)
    const size_t kstep = (size_t)(BK * 2);
    const size_t hstep = (size_t)HALF * K * 2;
    const size_t tstep = 2 * hstep;
    const size_t hstepA = (size_t)HALF * lda * 2, tstepA = 2 * hstepA;
#define PG8_AK(t_) ((size_t)(t_) * kstep + ((t_) >= nsplit ? (size_t)adelta : (size_t)0))
    const unsigned ldsw = (unsigned)wid * 1024u;
    const int aoff = lds_byte(wr * 64 + fr, fq * 8), boff = lds_byte(wc * 32 + fr, fq * 8);
#define PG8_SA(b, h) (((b) * 2 + (h)) * HTB)
#define PG8_SB(b, h) ((4 + (b) * 2 + (h)) * HTB)
#define PG8_STAGE(bufoff, gbase, voff) do { _Pragma("unroll") for (int _i = 0; _i < 2; ++_i) \
        __builtin_amdgcn_global_load_lds((const unsigned*)((const char*)(gbase) + (voff)[_i]), (PG8_LAS unsigned*)(lds + (bufoff) + ldsw + _i * 8192), 16, 0, 0); } while (0)
#define PG8_LDA(dst, b, h) do { _Pragma("unroll") for (int m = 0; m < 4; ++m) _Pragma("unroll") for (int k = 0; k < 2; ++k) dst[m][k] = *(const PG8_LAS bf16x8*)(lds + PG8_SA(b, h) + aoff + m * 2048 + k * 1024); } while (0)
#define PG8_LDB(dst, b, h) do { _Pragma("unroll") for (int n = 0; n < 2; ++n) _Pragma("unroll") for (int k = 0; k < 2; ++k) dst[n][k] = *(const PG8_LAS bf16x8*)(lds + PG8_SB(b, h) + boff + n * 2048 + k * 1024); } while (0)
#define PG8_MMA(ai, bj, At, Bt) do { __builtin_amdgcn_s_setprio(1); _Pragma("unroll") for (int m = 0; m < 4; ++m) _Pragma("unroll") for (int n = 0; n < 2; ++n) _Pragma("unroll") for (int k = 0; k < 2; ++k) \
        acc[ai][bj][m][n] = __builtin_amdgcn_mfma_f32_16x16x32_bf16(Bt[n][k], At[m][k], acc[ai][bj][m][n], 0, 0, 0); __builtin_amdgcn_s_setprio(0); } while (0)
#define PG8_WAIT_V(n) asm volatile("s_waitcnt vmcnt(" #n ")" ::: "memory")
#define PG8_WAIT_L(n) asm volatile("s_waitcnt lgkmcnt(" #n ")" ::: "memory")
#define PG8_BAR __builtin_amdgcn_s_barrier()
#define PG8_SCHED __builtin_amdgcn_sched_barrier(0)
    Unit cur, nxt; int ui = 0;
    if (!S.next(0, cur)) return;
    f32x4 acc[2][2][4][2];
#pragma unroll
    for (int a = 0; a < 2; ++a)
#pragma unroll
        for (int b = 0; b < 2; ++b)
#pragma unroll
            for (int m = 0; m < 4; ++m)
#pragma unroll
                for (int n = 0; n < 2; ++n) acc[a][b][m][n] = (f32x4){0.f, 0.f, 0.f, 0.f};
    bf16x8 At[4][2], B0[2][2], B1[2][2];
    const char* cA = S.aptr(g, cur, tstepA); const char* cB = S.bptr(g, cur, tstep);
    S.a_ready(cur);
    if constexpr (SP2) {
        PG8_STAGE(PG8_SB(0, 0), cB, voffB); PG8_STAGE(PG8_SB(0, 1), cB + hstep, voffB); PG8_STAGE_A(PG8_SA(0, 0), cA, 0, 0); PG8_STAGE_A(PG8_SA(0, 1), cA, 1, 0);
        if (wr == 1) PG8_BAR;
        PG8_WAIT_V(2); PG8_BAR;
        PG8_STAGE(PG8_SB(1, 0), cB + kstep, voffB); PG8_STAGE_A(PG8_SA(1, 0), cA + PG8_AK(1), 0, 0); PG8_STAGE(PG8_SB(1, 1), cB + hstep + kstep, voffB);
        PG8_WAIT_V(6); PG8_BAR;
    } else {
        PG8_STAGE(PG8_SB(0, 0), cB, voffB); PG8_STAGE(PG8_SA(0, 0), cA, voffA); PG8_STAGE(PG8_SB(0, 1), cB + hstep, voffB); PG8_STAGE(PG8_SA(0, 1), cA + hstep, voffA);
        if (wr == 1) PG8_BAR;
        PG8_WAIT_V(4); PG8_BAR;
        PG8_STAGE(PG8_SB(1, 0), cB + kstep, voffB); PG8_STAGE(PG8_SA(1, 0), cA + kstep, voffA); PG8_STAGE(PG8_SB(1, 1), cB + hstep + kstep, voffB);
        PG8_WAIT_V(6); PG8_BAR;
    }
    for (;;) {
        const bool has_next = S.next(ui + 1, nxt);
        const char* nA = has_next ? S.aptr(g, nxt, tstepA) : cA; const char* nB = has_next ? S.bptr(g, nxt, tstep) : cB;
        if constexpr (GATHER) {
#pragma unroll
            for (int h = 0; h < 2; ++h)
#pragma unroll
                for (int i = 0; i < 2; ++i) gN[h][i] = has_next ? (unsigned)S.arow(ui + 1, h * HALF + gR[i]) * (unsigned)(K * 2) + (unsigned)gC[i] : gA[h][i];
        }
        for (int t = 0; t < nt; t += 2) {
            const bool last = (t == nt - 2);
            const char* a1 = cA + PG8_AK(t + 1);
            const char* a2 = last ? nA : cA + PG8_AK(t + 2); const char* b2 = last ? nB : cB + (size_t)(t + 2) * kstep;
            const char* a3 = last ? nA + PG8_AK(1) : cA + PG8_AK(t + 3); const char* b3 = b2 + kstep;
            if (last && has_next) S.a_ready(nxt);
            if constexpr (GATHER) {
#pragma unroll
                for (int i = 0; i < 2; ++i) { oN0[i] = last ? gN[0][i] : gA[0][i]; oN1[i] = last ? gN[1][i] : gA[1][i]; }
            }
            if constexpr (SP2) {
            PG8_LDB(B0, 0, 0); PG8_LDB(B1, 0, 1); PG8_SCHED; PG8_LDA(At, 0, 0); PG8_STAGE_A(PG8_SA(1, 1), a1, 1, 0);
            PG8_WAIT_V(8); PG8_WAIT_L(0); PG8_BAR; PG8_MMA(0, 0, At, B0); PG8_MMA(0, 1, At, B1); PG8_BAR; PG8_SCHED;
            PG8_LDA(At, 0, 1); PG8_STAGE(PG8_SB(0, 0), b2, voffB); PG8_STAGE(PG8_SB(0, 1), b2 + hstep, voffB); PG8_STAGE_A(PG8_SA(0, 0), a2, 0, 1);
            PG8_WAIT_V(8); PG8_WAIT_L(0); PG8_BAR; PG8_MMA(1, 0, At, B0); PG8_MMA(1, 1, At, B1); PG8_BAR; PG8_SCHED;
            PG8_LDB(B0, 1, 0); PG8_LDB(B1, 1, 1); PG8_SCHED; PG8_LDA(At, 1, 0); PG8_STAGE_A(PG8_SA(0, 1), a2, 1, 1);
            PG8_WAIT_V(8); PG8_WAIT_L(0); PG8_BAR; PG8_MMA(0, 0, At, B0); PG8_MMA(0, 1, At, B1); PG8_BAR; PG8_SCHED;
            PG8_LDA(At, 1, 1); PG8_STAGE(PG8_SB(1, 0), b3, voffB); PG8_STAGE(PG8_SB(1, 1), b3 + hstep, voffB); PG8_STAGE_A(PG8_SA(1, 0), a3, 0, 1);
            PG8_WAIT_V(8); PG8_WAIT_L(0); PG8_BAR; PG8_MMA(1, 0, At, B0); PG8_MMA(1, 1, At, B1); PG8_BAR; PG8_SCHED;
            } else {
            PG8_LDB(B0, 0, 0); PG8_SCHED; PG8_LDA(At, 0, 0); PG8_STAGE(PG8_SA(1, 1), a1 + hstep, voffA);
            PG8_WAIT_L(8); PG8_BAR; PG8_WAIT_L(0); PG8_MMA(0, 0, At, B0); PG8_BAR; PG8_SCHED;
            PG8_LDB(B1, 0, 1); PG8_STAGE(PG8_SB(0, 0), b2, voffB);
            PG8_BAR; PG8_WAIT_L(0); PG8_MMA(0, 1, At, B1); PG8_BAR;
            PG8_LDA(At, 0, 1); PG8_STAGE(PG8_SA(0, 0), a2, voffA);
            PG8_BAR; PG8_WAIT_L(0); PG8_MMA(1, 0, At, B0); PG8_BAR; PG8_SCHED;
            PG8_STAGE(PG8_SB(0, 1), b2 + hstep, voffB);
            PG8_WAIT_V(6); PG8_BAR; PG8_MMA(1, 1, At, B1); PG8_BAR;
            PG8_LDB(B0, 1, 0); PG8_SCHED; PG8_LDA(At, 1, 0); PG8_STAGE(PG8_SA(0, 1), a2 + hstep, voffA);
            PG8_WAIT_L(8); PG8_BAR; PG8_WAIT_L(0); PG8_MMA(0, 0, At, B0); PG8_BAR; PG8_SCHED;
            PG8_LDB(B1, 1, 1); PG8_STAGE(PG8_SB(1, 0), b3, voffB);
            PG8_BAR; PG8_WAIT_L(0); PG8_MMA(0, 1, At, B1); PG8_BAR;
            PG8_LDA(At, 1, 1); PG8_STAGE(PG8_SA(1, 0), a3, voffA);
            PG8_BAR; PG8_WAIT_L(0); PG8_MMA(1, 0, At, B0); PG8_BAR; PG8_SCHED;
            PG8_STAGE(PG8_SB(1, 1), b3 + hstep, voffB);
            PG8_WAIT_V(6); PG8_BAR; PG8_MMA(1, 1, At, B1); PG8_BAR;
            }
        }
        if constexpr (ALIGN_EPI) { if (wr == 0) PG8_BAR; }
        if constexpr (!Epi::AFTER_DRAIN) { E(acc, cur, wr, wc, fr, fq); S.done(cur); }
        if (!has_next) break;
#pragma unroll
        for (int a = 0; a < 2; ++a)
#pragma unroll
            for (int b = 0; b < 2; ++b)
#pragma unroll
                for (int m = 0; m < 4; ++m)
#pragma unroll
                    for (int n = 0; n < 2; ++n) acc[a][b][m][n] = (f32x4){0.f, 0.f, 0.f, 0.f};
        cur = nxt; cA = nA; cB = nB; ++ui;
        if constexpr (GATHER) {
#pragma unroll
            for (int h = 0; h < 2; ++h)
#pragma unroll
                for (int i = 0; i < 2; ++i) gA[h][i] = gN[h][i];
        }
        if constexpr (ALIGN_EPI) { if (wr == 1) PG8_BAR; }
    }
    PG8_WAIT_V(0);
    if constexpr (!ALIGN_EPI) { if (wr == 0) PG8_BAR; }
    PG8_BAR;
    if constexpr (Epi::AFTER_DRAIN) { E.fused(acc, cur, wr, wc, fr, fq, lds, wid, lane); S.done(cur); }
#undef PG8_SA
#undef PG8_SB
#undef PG8_STAGE
#undef PG8_STAGE_A
#undef PG8_AK
#undef PG8_LDA
#undef PG8_LDB
#undef PG8_MMA
#undef PG8_WAIT_V
#undef PG8_WAIT_L
#undef PG8_BAR
#undef PG8_SCHED
}
}
#include <hip/hip_bf16.h>
#include <cmath>
namespace attn_body {
using bf16=__hip_bfloat16;
using bf16x8=__attribute__((ext_vector_type(8)))short;
using s16x4=__attribute__((ext_vector_type(4)))short;
using f32x16=__attribute__((ext_vector_type(16)))float;
using u32x4=__attribute__((ext_vector_type(4)))unsigned;
using f32x4=__attribute__((ext_vector_type(4)))float;
constexpr int D=64,QP=512,KVP=128,OP=512,SEQQ=4096,SEQK=4352;
constexpr int NW=8,QBLK=32,QB=QBLK*NW,KVBLK=64,NQB=SEQQ/QB;
constexpr int ATTN_UNIT_ROWS=QB;
__device__ __forceinline__ int crow(int r,int hi){return (r&3)+8*(r>>2)+4*hi;}
#define SBAR() __builtin_amdgcn_sched_barrier(0)
__device__ __forceinline__ void cmask(f32x16&p0,f32x16&p1,int jb,int qrel,int hi){
  const float NEG=-INFINITY; int kb=64*jb+4*hi;
  #pragma unroll
  for(int r=0;r<16;++r){int kv=kb+(r&3)+8*(r>>2); if(kv>qrel)p0[r]=NEG; if(kv+32>qrel)p1[r]=NEG;}
}

constexpr int NSLOT=3, SLOTB=8192;
constexpr int LDS_K=0, LDS_V=NSLOT*SLOTB, LDS_WS=2*NSLOT*SLOTB, LDS_OST=LDS_WS+NW*64*4, LDS_BYTES=LDS_OST+NW*4096;
constexpr float C2=0.125f*1.4426950408889634f;
__device__ __forceinline__ void glds16(const void*gsrc,unsigned lds_dst){unsigned keep;
  asm volatile("s_mov_b32 %0, m0\n\ts_mov_b32 m0, %2\n\ts_nop 0\n\tglobal_load_lds_dwordx4 %1, off\n\ts_mov_b32 m0, %0":"=&s"(keep):"v"(gsrc),"s"(lds_dst):"memory");}
__device__ __forceinline__ float max3f(float a,float b,float c){float r;asm("v_max3_f32 %0, %1, %2, %3":"=v"(r):"v"(a),"v"(b),"v"(c));return r;}
__device__ __forceinline__ float max2f(float a,float b){float r;asm("v_max_f32_e32 %0, %1, %2":"=v"(r):"v"(a),"v"(b));return r;}
__device__ __forceinline__ float fadd_s(float a,float b){float r;asm("v_add_f32_e32 %0, %1, %2":"=v"(r):"v"(a),"v"(b));return r;}
__device__ __forceinline__ float fsub_s(float a,float b){float r;asm("v_sub_f32_e32 %0, %1, %2":"=v"(r):"v"(a),"v"(b));return r;}
typedef float f32x2_t __attribute__((ext_vector_type(2))); typedef __bf16 bf16x2_t __attribute__((ext_vector_type(2)));
__device__ __forceinline__ unsigned cvtpk_s(float lo,float hi){f32x2_t v={lo,hi};bf16x2_t b=__builtin_convertvector(v,bf16x2_t);return __builtin_bit_cast(unsigned,b);}
#define WAIT_BAR(N) asm volatile("s_waitcnt vmcnt(" #N ") lgkmcnt(0)\n\ts_barrier":::"memory")

__device__ __forceinline__ void qkt(f32x16&p0,f32x16&p1,const char*Kslot,const bf16x8*qr,const f32x16&negm,int r32,int hi){
  const char*kb=Kslot+hi*1024+r32*16;
  #pragma unroll
  for(int d0=0;d0<4;++d0){
    const bf16x8 b0=*reinterpret_cast<const bf16x8*>(kb+d0*2048);
    const bf16x8 b1=*reinterpret_cast<const bf16x8*>(kb+d0*2048+512);
    if(d0==0){p0=__builtin_amdgcn_mfma_f32_32x32x16_bf16(b0,qr[0],negm,0,0,0);p1=__builtin_amdgcn_mfma_f32_32x32x16_bf16(b1,qr[0],negm,0,0,0);}
    else{p0=__builtin_amdgcn_mfma_f32_32x32x16_bf16(b0,qr[d0],p0,0,0,0);p1=__builtin_amdgcn_mfma_f32_32x32x16_bf16(b1,qr[d0],p1,0,0,0);}}
}
typedef __attribute__((address_space(3))) const char* lds_cptr;
typedef short v4i16_t __attribute__((ext_vector_type(4)));
__device__ __forceinline__ void kload8(bf16x8*kf,lds_cptr kp){
  kf[0]=*(const __attribute__((address_space(3))) bf16x8*)(kp);      kf[1]=*(const __attribute__((address_space(3))) bf16x8*)(kp+512);
  kf[2]=*(const __attribute__((address_space(3))) bf16x8*)(kp+2048); kf[3]=*(const __attribute__((address_space(3))) bf16x8*)(kp+2560);
  kf[4]=*(const __attribute__((address_space(3))) bf16x8*)(kp+4096); kf[5]=*(const __attribute__((address_space(3))) bf16x8*)(kp+4608);
  kf[6]=*(const __attribute__((address_space(3))) bf16x8*)(kp+6144); kf[7]=*(const __attribute__((address_space(3))) bf16x8*)(kp+6656);
}
__device__ __forceinline__ void kload2(bf16x8*kf,lds_cptr kp,int j){ kf[2*j]=*(const __attribute__((address_space(3))) bf16x8*)(kp+j*2048); kf[2*j+1]=*(const __attribute__((address_space(3))) bf16x8*)(kp+j*2048+512); }
__device__ __forceinline__ s16x4 vtr(lds_cptr p){ return __builtin_bit_cast(s16x4,__builtin_amdgcn_ds_read_tr16_b64_v4i16((__attribute__((address_space(3))) v4i16_t*)p)); }
__device__ __forceinline__ float rowmax(const f32x16&p0,const f32x16&p1){
  float a=max3f(p0[0],p0[1],p1[0]),b=max3f(p0[2],p0[3],p1[1]);a=max3f(a,p1[2],p1[3]);
  #pragma unroll
  for(int r=4;r<16;r+=4){a=max3f(a,p0[r],p0[r+1]);b=max3f(b,p0[r+2],p0[r+3]);a=max3f(a,p1[r],p1[r+1]);b=max3f(b,p1[r+2],p1[r+3]);}
  const float m=max2f(a,b);
  auto rr=__builtin_amdgcn_permlane32_swap(__float_as_uint(m),__float_as_uint(m),false,false);
  return max2f(__uint_as_float(rr[0]),__uint_as_float(rr[1]));
}
__device__ __forceinline__ void pv(f32x16*o,int vb,bf16x8 pa0,bf16x8 pa1,bf16x8 pa2,bf16x8 pa3){
  #pragma unroll
  for(int d0=0;d0<2;++d0){s16x4 lo[4],hi[4];
    #pragma unroll
    for(int ks=0;ks<4;++ks){
      asm volatile("ds_read_b64_tr_b16 %0,%1 offset:%c2":"=&v"(lo[ks]):"v"(vb),"i"(d0*4096+ks*1024):"memory");
      asm volatile("ds_read_b64_tr_b16 %0,%1 offset:%c2":"=&v"(hi[ks]):"v"(vb),"i"(d0*4096+ks*1024+512):"memory");}
    asm volatile("s_waitcnt lgkmcnt(0)":::"memory");SBAR();
    #define PK(k) (bf16x8){lo[k][0],lo[k][1],lo[k][2],lo[k][3],hi[k][0],hi[k][1],hi[k][2],hi[k][3]}
    o[d0]=__builtin_amdgcn_mfma_f32_32x32x16_bf16(pa0,PK(0),o[d0],0,0,0);
    o[d0]=__builtin_amdgcn_mfma_f32_32x32x16_bf16(pa1,PK(1),o[d0],0,0,0);
    o[d0]=__builtin_amdgcn_mfma_f32_32x32x16_bf16(pa2,PK(2),o[d0],0,0,0);
    o[d0]=__builtin_amdgcn_mfma_f32_32x32x16_bf16(pa3,PK(3),o[d0],0,0,0);
    #undef PK
  }
}

#ifndef ATTN_STORE16
#define ATTN_STORE16(p,v) (*(u32x4*)(p)=(v))
#endif
template<int THRL> __device__ __forceinline__ void attn_unit(int b,int h,int qb,const bf16*Q,const bf16*__restrict__ K,const bf16*__restrict__ V,bf16*O,const float*__restrict__ og,char*shm){
  const int kvh=h>>2;
  const int tid=threadIdx.x,lane=tid&63,r32=lane&31,hi=lane>>5; const int wid=__builtin_amdgcn_readfirstlane(tid>>6);
  const long rowbase=(long)b*SEQQ, rowbasek=(long)b*SEQK; const int q0=qb*QB;
  const bf16*Qw=Q+(rowbase+q0+wid*QBLK)*QP+h*D;
  const bf16*Kh=K+rowbasek*KVP+kvh*D,*Vh=V+rowbasek*KVP+kvh*D;
  const unsigned lds0=(unsigned)(uintptr_t)shm;
  float*wsf=(float*)(shm+LDS_WS)+wid*64;
  const bf16*ksrc=Kh+(long)lane*KVP+wid*8;
  const bf16*vsrc=Vh+(long)(16*(wid&3)+(lane>>2))*KVP+(wid>>2)*32+(lane&3)*8;
  const unsigned kdst=lds0+LDS_K+wid*1024, vdst=lds0+LDS_V+wid*1024;
  #define DMA_K(t,slot) glds16(ksrc+(long)(t)*KVBLK*KVP,(unsigned)__builtin_amdgcn_readfirstlane(kdst+(slot)))
  #define DMA_V(t,slot) glds16(vsrc+(long)(t)*KVBLK*KVP,(unsigned)__builtin_amdgcn_readfirstlane(vdst+(slot)))
  const int vb0=(int)(lds0+LDS_V)+((lane>>4)&1)*32+(lane&3)*8+(4*hi+((lane&15)>>2))*64;
  const char*Kbase=shm+LDS_K; bf16x8 kf[8];
  const lds_cptr shm3=(lds_cptr)shm; const lds_cptr kp0=shm3+LDS_K+hi*1024+r32*16; const lds_cptr vp0=shm3+LDS_V+((lane>>4)&1)*32+(lane&3)*8+(4*hi+((lane&15)>>2))*64;
  constexpr int NT=SEQK/KVBLK;
  DMA_K(0,0);DMA_V(0,0);DMA_K(1,SLOTB);
  bf16x8 qr[4];
  #pragma unroll
  for(int d0=0;d0<4;++d0)qr[d0]=*reinterpret_cast<const bf16x8*>(&Qw[(long)r32*QP+d0*16+hi*8]);
  float mhat=0.f,l_reg=0.f;f32x16 o[2];o[0]=f32x16{};o[1]=f32x16{};f32x16 negm=f32x16{};asm volatile("":"+v"(negm));
  #define CMASK(P0,P1,t) do{}while(0)
  bool resc=false;
  #define START(P0,P1) do{ const float rm=rowmax(P0,P1); resc=false; \
    { const float dl=rm; mhat=fadd_s(mhat,dl); \
      _Pragma("unroll") for(int r=0;r<16;++r){P0[r]=fsub_s(P0[r],dl);P1[r]=fsub_s(P1[r],dl);} \
      _Pragma("unroll") for(int r=0;r<16;++r)negm[r]=-mhat; asm volatile("":"+v"(negm)); } \
    _Pragma("unroll") for(int r=0;r<16;++r)P0[r]=__builtin_amdgcn_exp2f(P0[r]); }while(0)
  #define RESC() do{ if(resc){ asm volatile("s_waitcnt lgkmcnt(0)":::"memory"); \
      _Pragma("unroll") for(int d_=0;d_<2;++d_) _Pragma("unroll") for(int r=0;r<16;++r)o[d_][r]*=wsf[crow(r,hi)]; } }while(0)
  f32x16 pA0,pA1,pB0,pB1;
  int sl_prev=0,sl_cur=0,sl_next=SLOTB;
  #define ROT() do{sl_prev=sl_cur;sl_cur=sl_next;sl_next=(sl_next==(NSLOT-1)*SLOTB)?0:sl_next+SLOTB;}while(0)
  DMA_K(2,2*SLOTB);
  WAIT_BAR(3);
  qkt(pA0,pA1,Kbase,qr,negm,r32,hi);asm volatile("s_nop 15\n\ts_nop 7":"+v"(pA0),"+v"(pA1));CMASK(pA0,pA1,0);
  START(pA0,pA1);
  _Pragma("unroll") for(int r=0;r<16;++r)pA1[r]=__builtin_amdgcn_exp2f(pA1[r]);
  WAIT_BAR(0);
  DMA_K(3,0);DMA_V(1,SLOTB);
  ROT();
  kload8(kf,kp0+sl_cur);
  WAIT_BAR(2);
  s16x4 vlo[8],vhi[8]; u32x4 pw0,pw1,pw2,pw3;
  #define PKW(P,B) cvtpk_s(P[B],P[B+1])
  #define PAF(k) __builtin_bit_cast(bf16x8,pw##k)
  #define VFR(i) (bf16x8){vlo[i][0],vlo[i][1],vlo[i][2],vlo[i][3],vhi[i][0],vhi[i][1],vhi[i][2],vhi[i][3]}
  #define PIN(x) asm volatile("":"+v"(x))
  #define MX3(a,b,c) __builtin_fmaxf(__builtin_fmaxf((a),(b)),(c))
  #define GAPA(MF,A0,A1,A2,A3,W0,W1,PW) do{ MF; sacc+=A0; sacc+=A1; sacc+=A2; sacc+=A3; PIN(sacc); W0; W1; PIN(PW); SBAR(); }while(0)
  #define EX(v) __builtin_amdgcn_exp2f(v)
  #define GAPB(MF,X,B) do{ MF; X[B]=EX(X[B]); X[B+1]=EX(X[B+1]); X[B+2]=EX(X[B+2]); X[B+3]=EX(X[B+3]); PIN(X); SBAR(); }while(0)
  #define VRD(i) do{ vlo[i]=vtr(vp_+(((i)>>2)*4096+((i)&3)*1024)); vhi[i]=vtr(vp_+(((i)>>2)*4096+((i)&3)*1024+512)); }while(0)
  #define KRD(G,j) do{ if(G){ kload2(kf,kp0+sl_next,j); SBAR(); } }while(0)
  #define STEP(C0,C1,P0,P1,t,GK,GV,GL) do{ SBAR(); \
    const lds_cptr vp_=vp0+sl_prev; \
    VRD(0); SBAR(); float sacc=(P0[0]+P0[1]); \
    GAPA(C0=__builtin_amdgcn_mfma_f32_32x32x16_bf16(kf[0],qr[0],negm,0,0,0), P0[2],P0[3],P0[4],P0[5],     pw0[0]=PKW(P0,0), pw0[1]=PKW(P0,2), pw0); \
    VRD(4); SBAR(); GAPA(C1=__builtin_amdgcn_mfma_f32_32x32x16_bf16(kf[1],qr[0],negm,0,0,0), P0[6],P0[7],P0[8],P0[9],     pw0[2]=PKW(P0,4), pw0[3]=PKW(P0,6), pw0); \
    VRD(1); SBAR(); GAPA(C0=__builtin_amdgcn_mfma_f32_32x32x16_bf16(kf[2],qr[1],C0,0,0,0),   P0[10],P0[11],P0[12],P0[13], pw1[0]=PKW(P0,8), pw1[1]=PKW(P0,10), pw1); \
    VRD(5); SBAR(); GAPA(C1=__builtin_amdgcn_mfma_f32_32x32x16_bf16(kf[3],qr[1],C1,0,0,0),   P0[14],P0[15],P1[0],P1[1],   pw1[2]=PKW(P0,12),pw1[3]=PKW(P0,14), pw1); \
    VRD(2); SBAR(); GAPA(C0=__builtin_amdgcn_mfma_f32_32x32x16_bf16(kf[4],qr[2],C0,0,0,0),   P1[2],P1[3],P1[4],P1[5],     pw2[0]=PKW(P1,0), pw2[1]=PKW(P1,2), pw2); \
    VRD(6); SBAR(); GAPA(C1=__builtin_amdgcn_mfma_f32_32x32x16_bf16(kf[5],qr[2],C1,0,0,0),   P1[6],P1[7],P1[8],P1[9],     pw2[2]=PKW(P1,4), pw2[3]=PKW(P1,6), pw2); \
    VRD(3); SBAR(); GAPA(C0=__builtin_amdgcn_mfma_f32_32x32x16_bf16(kf[6],qr[3],C0,0,0,0),   P1[10],P1[11],P1[12],P1[13], pw3[0]=PKW(P1,8), pw3[1]=PKW(P1,10), pw3); \
    VRD(7); SBAR(); GAPA(C1=__builtin_amdgcn_mfma_f32_32x32x16_bf16(kf[7],qr[3],C1,0,0,0),   P1[14],P1[15],0.f,0.f,       pw3[2]=PKW(P1,12),pw3[3]=PKW(P1,14), pw3); \
    l_reg+=sacc; \
    if(GK){DMA_K((t)+3,sl_cur);} if(GV){DMA_V((t)+1,sl_next);} \
    CMASK(C0,C1,t); \
    { float a=MX3(C0[0],C0[1],C1[0]),b=MX3(C0[2],C0[3],C1[1]); a=MX3(a,C1[2],C1[3]); \
      _Pragma("unroll") for(int r=4;r<16;r+=4){a=MX3(a,C0[r],C0[r+1]);b=MX3(b,C0[r+2],C0[r+3]);a=MX3(a,C1[r],C1[r+1]);b=MX3(b,C1[r+2],C1[r+3]);} \
      float rm=__builtin_fmaxf(a,b); { auto rr=__builtin_amdgcn_permlane32_swap(__float_as_uint(rm),__float_as_uint(rm),false,false); rm=__builtin_fmaxf(__uint_as_float(rr[0]),__uint_as_float(rr[1])); } \
      resc=false; \
      if(__builtin_expect(__any(rm>(float)THRL),0)){ const float dl=__builtin_fmaxf(rm,0.f); mhat+=dl; \
        _Pragma("unroll") for(int r=0;r<16;++r){C0[r]-=dl;C1[r]-=dl;} \
        _Pragma("unroll") for(int r=0;r<16;++r)negm[r]=-mhat; asm volatile("":"+v"(negm)); \
        const float f=__builtin_amdgcn_exp2f(-dl); l_reg*=f; if(hi==0)wsf[r32]=f; resc=true; } } \
    SBAR(); \
    GAPB(o[0]=__builtin_amdgcn_mfma_f32_32x32x16_bf16(PAF(0),VFR(0),o[0],0,0,0), C0,0); \
    GAPB(o[1]=__builtin_amdgcn_mfma_f32_32x32x16_bf16(PAF(0),VFR(4),o[1],0,0,0), C0,4); \
    KRD(GL,0); GAPB(o[0]=__builtin_amdgcn_mfma_f32_32x32x16_bf16(PAF(1),VFR(1),o[0],0,0,0), C0,8); \
    KRD(GL,1); GAPB(o[1]=__builtin_amdgcn_mfma_f32_32x32x16_bf16(PAF(1),VFR(5),o[1],0,0,0), C0,12); \
    KRD(GL,2); GAPB(o[0]=__builtin_amdgcn_mfma_f32_32x32x16_bf16(PAF(2),VFR(2),o[0],0,0,0), C1,0); \
    KRD(GL,3); GAPB(o[1]=__builtin_amdgcn_mfma_f32_32x32x16_bf16(PAF(2),VFR(6),o[1],0,0,0), C1,4); \
    GAPB(o[0]=__builtin_amdgcn_mfma_f32_32x32x16_bf16(PAF(3),VFR(3),o[0],0,0,0), C1,8); \
    GAPB(o[1]=__builtin_amdgcn_mfma_f32_32x32x16_bf16(PAF(3),VFR(7),o[1],0,0,0), C1,12); \
    }while(0)
  int t=1;
  #undef CMASK
  #define CMASK(P0,P1,t) do{}while(0)
  for(;t+5<NT;t+=2){
    STEP(pB0,pB1,pA0,pA1,t,true,true,true);     WAIT_BAR(2); RESC(); ROT();
    STEP(pA0,pA1,pB0,pB1,t+1,true,true,true);   WAIT_BAR(2); RESC(); ROT();
  }
  #undef CMASK
  #define CMASK(P0,P1,t) do{}while(0)
  #define ENDW(tt) do{ if((tt)+3<NT){WAIT_BAR(2);} else if((tt)+2<NT){WAIT_BAR(1);} else {WAIT_BAR(0);} }while(0)
  for(;t+1<NT;t+=2){
    STEP(pB0,pB1,pA0,pA1,t,(t+3<NT),(t+1<NT),(t+1<NT));       ENDW(t);   RESC(); ROT();
    STEP(pA0,pA1,pB0,pB1,t+1,(t+4<NT),(t+2<NT),(t+2<NT));     ENDW(t+1); RESC(); ROT();
  }
  STEP(pB0,pB1,pA0,pA1,NT-1,false,false,false); RESC();
  { float sacc=pB0[0]+pB0[1]; _Pragma("unroll") for(int r=2;r<16;++r)sacc+=pB0[r]; _Pragma("unroll") for(int r=0;r<16;++r)sacc+=pB1[r]; l_reg+=sacc;
    pw0=(u32x4){PKW(pB0,0),PKW(pB0,2),PKW(pB0,4),PKW(pB0,6)};pw1=(u32x4){PKW(pB0,8),PKW(pB0,10),PKW(pB0,12),PKW(pB0,14)};pw2=(u32x4){PKW(pB1,0),PKW(pB1,2),PKW(pB1,4),PKW(pB1,6)};pw3=(u32x4){PKW(pB1,8),PKW(pB1,10),PKW(pB1,12),PKW(pB1,14)};
    SBAR(); pv(o,vb0+sl_cur,PAF(0),PAF(1),PAF(2),PAF(3)); }
  #undef PKW
  #undef PAF
  #undef VFR
  #undef PIN
  #undef MX3
  #undef GAPA
  #undef GAPB
  #undef EX
  #undef VRD
  #undef KRD
  #undef STEP
  #undef ENDW
  {auto rr=__builtin_amdgcn_permlane32_swap(__float_as_uint(l_reg),__float_as_uint(l_reg),false,false);l_reg=__uint_as_float(rr[0])+__uint_as_float(rr[1]);}
  if(hi==0)wsf[32+r32]=l_reg;asm volatile("s_waitcnt lgkmcnt(0)":::"memory");
  float rli[16];
  #pragma unroll
  for(int r=0;r<16;++r)rli[r]=__builtin_amdgcn_rcpf(wsf[32+crow(r,hi)]);
  bf16*Ow=O+(rowbase+q0+wid*QBLK)*OP+h*D;
  { bf16*stg=(bf16*)(shm+LDS_OST)+wid*2048;
    #pragma unroll
    for(int r=0;r<16;++r){const int orow=crow(r,hi);
      #pragma unroll
      for(int d0=0;d0<2;++d0)stg[orow*64+d0*32+r32]=__float2bfloat16(o[d0][r]*rli[r]);}
    asm volatile("s_waitcnt lgkmcnt(0)":::"memory");
    const f32x4 og0=*(const f32x4*)(og+h*64+(lane&7)*8), og1=*(const f32x4*)(og+h*64+(lane&7)*8+4);
    #pragma unroll
    for(int i=0;i<4;++i){const int row=i*8+(lane>>3),ch=lane&7; const u32x4 v=*(const u32x4*)(stg+row*64+ch*8);
      const unsigned w[4]={v.x,v.y,v.z,v.w}; float x[8]; float ss=0.f;
      #pragma unroll
      for(int p=0;p<4;++p){x[2*p]=__uint_as_float(w[p]<<16);x[2*p+1]=__uint_as_float(w[p]&0xffff0000u);ss+=x[2*p]*x[2*p]+x[2*p+1]*x[2*p+1];}
      ss+=__shfl_xor(ss,1);ss+=__shfl_xor(ss,2);ss+=__shfl_xor(ss,4);
      const float rs=rsqrtf(ss*(1.f/64.f)+1e-6f);
      u32x4 o4; o4.x=cvtpk_s(x[0]*rs*og0[0],x[1]*rs*og0[1]); o4.y=cvtpk_s(x[2]*rs*og0[2],x[3]*rs*og0[3]); o4.z=cvtpk_s(x[4]*rs*og1[0],x[5]*rs*og1[1]); o4.w=cvtpk_s(x[6]*rs*og1[2],x[7]*rs*og1[3]);
      ATTN_STORE16(Ow+(long)row*OP+ch*8,o4);} }
  asm volatile("s_waitcnt lgkmcnt(0)\n\ts_barrier":::"memory");
  #undef DMA_K
  #undef DMA_V
  #undef CMASK
  #undef START
  #undef RESC
  #undef ROT
}
constexpr int ATTN_LDS_BYTES=LDS_BYTES;
struct AttnTensors { const bf16* Q; const bf16* K; const bf16* V; bf16* O; const float* og; };
struct AttnUnit { int bh; int qb; };
struct StaticOrder {
  int vcu;
  __device__ __forceinline__ explicit StaticOrder(int grid,int block):vcu((block%8)*(grid/8)+block/8){}
  __device__ __forceinline__ bool next(int i,AttnUnit&u)const{ if(i>=4)return false; const int w=32*i+(vcu&31); u.bh=(vcu>>5)*8+(w>>4); u.qb=w&15; return true; }
  __device__ __forceinline__ void a_ready(const AttnUnit&)const{}
  __device__ __forceinline__ void done(const AttnUnit&)const{}
};
template<class Sched,int THRL=8> __device__ __forceinline__ void attn_phase(char*lds,const AttnTensors&T,const Sched&S){
  AttnUnit u;
  for(int i=0;S.next(i,u);++i){ S.a_ready(u); attn_unit<THRL>(u.bh>>3,u.bh&7,u.qb,T.Q,T.K,T.V,T.O,T.og,lds); S.done(u); }
}
#undef SBAR
#undef WAIT_BAR
}
constexpr int NWAVES = 8;
constexpr int RING_OFF = 0, RING_BYTES = 131072;
constexpr int ROPE_OFF = RING_BYTES;
constexpr int MISC_OFF = ROPE_OFF + 8192;
constexpr int XTRA_OFF = 147456;
constexpr int LDS_BYTES = 163840;
#define LAS __attribute__((address_space(3)))
typedef unsigned v4u __attribute__((ext_vector_type(4)));
typedef unsigned v2u __attribute__((ext_vector_type(2)));
typedef float f32x4 __attribute__((ext_vector_type(4)));
#define LDS_WAIT() asm volatile("s_waitcnt lgkmcnt(0)" ::: "memory")
#define LBAR() do { asm volatile("s_waitcnt lgkmcnt(0)" ::: "memory"); __builtin_amdgcn_s_barrier(); asm volatile("" ::: "memory"); } while (0)

typedef short bf16x8_t __attribute__((ext_vector_type(8)));
#define XB_TMO      128
#define XB_XCNT(j)  (256  + 64 * (j))
#define XB_XSUB(j)  (1280 + 64 * (j))
#define XB_XGEN(j)  (2304 + 64 * (j))
#define XB_TOP      3328
#define XB_TOPGEN   3392
#define XCD_BAR_WORDS 3456
#define XB_SPIN_CAP (1u << 18)

__device__ __forceinline__ unsigned xb_ld(unsigned* p)              { return __hip_atomic_load(p, __ATOMIC_RELAXED, __HIP_MEMORY_SCOPE_AGENT); }
__device__ __forceinline__ unsigned xb_add(unsigned* p, unsigned v) { return __hip_atomic_fetch_add(p, v, __ATOMIC_RELAXED, __HIP_MEMORY_SCOPE_AGENT); }
__device__ __forceinline__ unsigned xb_xcc_id() { return (unsigned)__builtin_amdgcn_s_getreg((3 << 11) | 20) & 0xFu; }
#define XB_SPIN(cond, bar) do { unsigned _sp = 0; while (cond) { __builtin_amdgcn_s_sleep(1); \
    if ((++_sp & 255u) == 0u) { if (xb_ld(&(bar)[XB_TMO])) break; if (_sp > XB_SPIN_CAP) { atomicAdd(&(bar)[XB_TMO], 1u); break; } } } } while (0)

struct XcdBarrier {
    unsigned* bar; unsigned x;
    volatile LAS unsigned* st;
};

__device__ __forceinline__ XcdBarrier xcd_barrier_post(unsigned* bar, volatile LAS unsigned* st) {
    XcdBarrier b; b.bar = bar; b.x = xb_xcc_id(); b.st = st;
    if (threadIdx.x == 0) (void)xb_add(&bar[XB_XCNT(b.x)], 1u);
    return b;
}
__device__ __forceinline__ void xcd_barrier_complete(unsigned* bar, unsigned x, unsigned& nloc, unsigned& nx) {
    const unsigned G = gridDim.x * gridDim.y * gridDim.z;
    unsigned sum, cnt, mine, sp = 0u;
    for (;;) {
        sum = 0u; cnt = 0u; mine = 0u;
#pragma unroll
        for (unsigned j = 0; j < 16; ++j) { const unsigned c = xb_ld(&bar[XB_XCNT(j)]); sum += c; cnt += (c > 0u) ? 1u : 0u; mine = (j == x) ? c : mine; }
        if (sum == G) break;
        __builtin_amdgcn_s_sleep(1);
        if ((++sp & 255u) == 0u) { if (xb_ld(&bar[XB_TMO])) break; if (sp > XB_SPIN_CAP) { atomicAdd(&bar[XB_TMO], 1u); break; } }
    }
    nloc = mine > 0u ? mine : 1u; nx = cnt > 0u ? cnt : 1u;
}

__device__ __forceinline__ void xcd_barrier(const XcdBarrier& b) {
    asm volatile("s_waitcnt vmcnt(0)" ::: "memory");
    __syncthreads();
    if (threadIdx.x == 0) {
        unsigned* bar = b.bar;
        __builtin_amdgcn_s_waitcnt(0);
        unsigned nloc = b.st[0], nx = b.st[1];
        if (nloc == 0u) { xcd_barrier_complete(bar, b.x, nloc, nx); b.st[0] = nloc; b.st[1] = nx; }
        const unsigned old = xb_add(&bar[XB_XSUB(b.x)], 1u);
        const unsigned gen = old / nloc;
        if (old + 1u == (gen + 1u) * nloc) {
            __builtin_amdgcn_fence(__ATOMIC_RELEASE, "agent");
            asm volatile("s_waitcnt vmcnt(0)" ::: "memory");
            const unsigned og = xb_add(&bar[XB_TOP], 1u);
            const unsigned tg = og / nx;
            if (og + 1u == (tg + 1u) * nx) xb_add(&bar[XB_TOPGEN], 1u);
            else XB_SPIN(xb_ld(&bar[XB_TOPGEN]) == tg, bar);
            __builtin_amdgcn_fence(__ATOMIC_ACQUIRE, "agent");
            xb_add(&bar[XB_XGEN(b.x)], 1u);
            asm volatile("s_waitcnt vmcnt(0)" ::: "memory");
        } else {
            XB_SPIN(xb_ld(&bar[XB_XGEN(b.x)]) == gen, bar);
            __builtin_amdgcn_fence(__ATOMIC_ACQUIRE, "agent");
            asm volatile("s_waitcnt vmcnt(0)" ::: "memory");
        }
    }
    __syncthreads();
}

__device__ __forceinline__ int fresh_tid() { int t = threadIdx.x; asm volatile("" : "+v"(t)); return t; }
#define PHASE_IDS const int tid = fresh_tid(), lane = tid & 63, wave = __builtin_amdgcn_readfirstlane(tid >> 6); (void)lane; (void)wave;
struct Args { const float* in[22]; float* out; unsigned char* ws; int ph_lo, ph_hi; };

__device__ __forceinline__ void tr_load(f32x4 (&v)[8], const float* __restrict__ W, int ldw, int k0, int n0, int lane) {
    const float* src = W + (size_t)(k0 + (lane >> 3)) * ldw + n0 + 4 * (lane & 7);
#pragma unroll
    for (int i = 0; i < 8; ++i) v[i] = __builtin_nontemporal_load((const f32x4*)(src + (size_t)(8 * i) * ldw));
}
__device__ __forceinline__ void tr_finish(const f32x4 (&v)[8], int k0, bf16_t* WTrow0, int ldk, LAS float* scr, int lane) {
#pragma unroll
    for (int i = 0; i < 8; ++i) { LAS float* d = scr + (8 * i + (lane >> 3)) * 33 + 4 * (lane & 7); d[0] = v[i][0]; d[1] = v[i][1]; d[2] = v[i][2]; d[3] = v[i][3]; }
    LDS_WAIT(); asm volatile("" ::: "memory");
    const int c = lane & 7;
#pragma unroll
    for (int j = 0; j < 4; ++j) { const int n = (lane >> 3) + 8 * j; const LAS float* s = scr + (8 * c) * 33 + n;
        v4u o; o.x = pk2(s[0 * 33], s[1 * 33]); o.y = pk2(s[2 * 33], s[3 * 33]); o.z = pk2(s[4 * 33], s[5 * 33]); o.w = pk2(s[6 * 33], s[7 * 33]);
        *(v4u*)(WTrow0 + (size_t)n * ldk + k0 + 8 * c) = o; }
    LDS_WAIT(); asm volatile("" ::: "memory");
}
__device__ __forceinline__ void tr_item(const float* __restrict__ W, int ldw, int k0, int n0, bf16_t* WTrow0, int ldk, LAS float* scr, int lane) {
    f32x4 v[8]; tr_load(v, W, ldw, k0, n0, lane); tr_finish(v, k0, WTrow0, ldk, scr, lane);
}
struct TrDesc { const float* W; int ldw, k0, n0, ldk; bf16_t* dst; };
__device__ __forceinline__ TrDesc tr_expert_desc(int r, const float* weg, const float* weu, const float* wed, bf16_t* WGU, bf16_t* WDN) {
    TrDesc t; constexpr int I_G = 32 * 128;
    if (r < 2 * I_G) { const bool up = r >= I_G; const int rr = up ? r - I_G : r, e = rr >> 7, q = rr & 127, kb = q >> 3, nb = q & 7, n0 = 64 * nb;
        t.W = (up ? weu : weg) + (size_t)e * 1024 * 512; t.ldw = 512; t.k0 = 64 * kb; t.n0 = n0; t.ldk = 1024; t.dst = WGU + ((size_t)e * 1024 + 256 * (n0 >> 7) + (up ? 128 : 0) + (n0 & 127)) * 1024; }
    else { const int rr = r - 2 * I_G, e = rr >> 7, q = rr & 127, kb = q >> 4, nb = q & 15;
        t.W = wed + (size_t)e * 512 * 1024; t.ldw = 1024; t.k0 = 64 * kb; t.n0 = 64 * nb; t.ldk = 512; t.dst = WDN + ((size_t)e * 1024 + 64 * nb) * 512; }
    return t;
}
__device__ __forceinline__ void tr_load64(f32x4 (&v)[16], const TrDesc& t, int lane) {
    const float* src = t.W + (size_t)(t.k0 + (lane >> 4)) * t.ldw + t.n0 + 4 * (lane & 15);
#pragma unroll
    for (int i = 0; i < 16; ++i) v[i] = __builtin_nontemporal_load((const f32x4*)(src + (size_t)(4 * i) * t.ldw));
}
__device__ __forceinline__ void tr_finish64(const f32x4 (&v)[16], const TrDesc& t, LAS float* scr, int lane) {
#pragma unroll
    for (int i = 0; i < 16; ++i) { LAS float* d = scr + (4 * i + (lane >> 4)) * 65 + 4 * (lane & 15); d[0] = v[i][0]; d[1] = v[i][1]; d[2] = v[i][2]; d[3] = v[i][3]; }
    LDS_WAIT(); asm volatile("" ::: "memory");
    const int c = lane & 7;
#pragma unroll
    for (int j = 0; j < 8; ++j) { const int n = (lane >> 3) + 8 * j; const LAS float* s = scr + (8 * c) * 65 + n;
        v4u o; o.x = pk2(s[0 * 65], s[1 * 65]); o.y = pk2(s[2 * 65], s[3 * 65]); o.z = pk2(s[4 * 65], s[5 * 65]); o.w = pk2(s[6 * 65], s[7 * 65]);
        *(v4u*)(t.dst + (size_t)n * t.ldk + t.k0 + 8 * c) = o; }
    LDS_WAIT(); asm volatile("" ::: "memory");
}
__device__ __forceinline__ int win_vc0(int n0) {
    if (n0 < 512) { const int head = n0 >> 6, dh = (n0 >> 5) & 1; return 256 * (head >> 2) + 128 * dh + 32 * (head & 3); }
    if (n0 < 640) { const int hh = (n0 - 512) >> 6, dh = ((n0 - 512) >> 5) & 1; return 512 + 128 * dh + 32 * hh; }
    if (n0 < 768) { const int hv = (n0 - 640) >> 6, dh = ((n0 - 640) >> 5) & 1; return 512 + 128 * dh + 32 * (hv + 2); }
    return n0;
}


constexpr int HQ_LD = 136, HK_LD = 72;
constexpr int HA_RAWG = 0, HA_RAWQ = 16384, HA_RAWV = 32768, HA_QT = 49152, HA_KT = HA_QT + 64 * HQ_LD * 2, HA_KHT = HA_KT + 64 * HQ_LD * 2, HA_VT = HA_KHT + 128 * HK_LD * 2, HA_AM = HA_VT + 128 * HK_LD * 2, HA_END = HA_AM + 64 * HK_LD * 2;
static_assert(HA_END <= 131072, "HGRN phase A LDS");
__device__ __forceinline__ float fexp_c(float x) { return __expf(fminf(x, 80.f)); }
__device__ __forceinline__ void hgrn_a_load(v4u (&rg)[6], int unit, const bf16_t* __restrict__ QR, const bf16_t* GF, const bf16_t* GB, const bf16_t* __restrict__ IV, int tid) {
    const int c = unit % NCHUNK, dir = (unit / NCHUNK) & 1, h = (unit / (2 * NCHUNK)) & 3, b = unit / (8 * NCHUNK);
    const bf16_t* G = dir ? GB : GF; const size_t rowb = (size_t)b * TPB + 64 * c;
#pragma unroll
    for (int i = 0; i < 2; ++i) { const int p = tid + 512 * i, j = p >> 4, ch = p & 15; const size_t off = (rowb + (dir ? 63 - j : j)) * 512 + h * 128 + ch * 8;
        rg[i] = __builtin_nontemporal_load((const v4u*)(G + off)); rg[2 + i] = __builtin_nontemporal_load((const v4u*)(QR + off)); rg[4 + i] = __builtin_nontemporal_load((const v4u*)(IV + off)); }
}
__device__ __forceinline__ void hgrn_a_unit(int unit, int next_unit, v4u (&rg)[6], const bf16_t* __restrict__ QR, bf16_t* GF, bf16_t* GB, const bf16_t* __restrict__ IV, bf16_t* ORF, bf16_t* ORB, bf16_t* UT, float* DEC, LAS unsigned char* lds, LAS float* qs, int tid) {
    const int c = unit % NCHUNK, dir = (unit / NCHUNK) & 1, h = (unit / (2 * NCHUNK)) & 3, b = unit / (8 * NCHUNK);
    const bool lat = c >= 4;
    const int d = tid & 127, qt = tid >> 7, lane = tid & 63, wave = __builtin_amdgcn_readfirstlane(tid >> 6), ln = lane & 15, lg = lane >> 4;
    bf16_t* G = dir ? GB : GF; bf16_t* OR = dir ? ORB : ORF;
    LAS bf16_t* RG = (LAS bf16_t*)(lds + HA_RAWG); LAS bf16_t* RQ = (LAS bf16_t*)(lds + HA_RAWQ); LAS bf16_t* RV = (LAS bf16_t*)(lds + HA_RAWV);
    LAS bf16_t* Qt = (LAS bf16_t*)(lds + HA_QT); LAS bf16_t* Kt = (LAS bf16_t*)(lds + HA_KT); LAS bf16_t* KhT = (LAS bf16_t*)(lds + HA_KHT);
    LAS bf16_t* VT = (LAS bf16_t*)(lds + HA_VT); LAS bf16_t* Am = (LAS bf16_t*)(lds + HA_AM);
    const size_t rowb = (size_t)b * TPB + 64 * c;
#pragma unroll
    for (int i = 0; i < 2; ++i) { const int p = tid + 512 * i; *(LAS v4u*)(RG + p * 8) = rg[i]; *(LAS v4u*)(RQ + p * 8) = rg[2 + i]; *(LAS v4u*)(RV + p * 8) = rg[4 + i]; }
    LBAR();
    typedef float f2 __attribute__((ext_vector_type(2)));
    const int dp = lane, d2 = 2 * dp, r8 = 8 * wave;
    f2 g[8], q[8]; unsigned v0[4], v1[4];
#pragma unroll
    for (int i = 0; i < 8; ++i) {
        const int j = r8 + i;
        const unsigned gw_ = *(const LAS unsigned*)(RG + j * 128 + d2), qw_ = *(const LAS unsigned*)(RQ + j * 128 + d2), vw_ = *(const LAS unsigned*)(RV + j * 128 + d2);
        g[i] = (f2){__uint_as_float(gw_ << 16), __uint_as_float(gw_ & 0xffff0000u)}; q[i] = (f2){__uint_as_float(qw_ << 16), __uint_as_float(qw_ & 0xffff0000u)};
        if (i & 1) { v0[i >> 1] |= vw_ << 16; v1[i >> 1] |= vw_ & 0xffff0000u; } else { v0[i >> 1] = vw_ & 0xffffu; v1[i >> 1] = vw_ >> 16; }
    }
    f2 bl[8]; f2 run = (f2){0.f, 0.f};
#pragma unroll
    for (int i = 0; i < 8; ++i) { run += g[i]; bl[i] = run; }
    *(LAS f2*)(qs + wave * 128 + d2) = run;
    *(LAS v4u*)(VT + d2 * HK_LD + r8) = (v4u){v0[0], v0[1], v0[2], v0[3]};
    *(LAS v4u*)(VT + (d2 + 1) * HK_LD + r8) = (v4u){v1[0], v1[1], v1[2], v1[3]};
    LBAR();
    if (next_unit >= 0) hgrn_a_load(rg, next_unit, QR, GF, GB, IV, tid);
    f2 off = (f2){0.f, 0.f}, bmid = (f2){0.f, 0.f}, bend = (f2){0.f, 0.f};
#pragma unroll
    for (int w = 0; w < 8; ++w) { const f2 t = *(const LAS f2*)(qs + w * 128 + d2); if (w < wave) off += t; if (w < 4) bmid += t; bend += t; }
    const f2 cmid = (f2){__expf(bmid.x), __expf(bmid.y)}, cend = (f2){__expf(bend.x - bmid.x), __expf(bend.y - bmid.y)};
    unsigned k0[4], k1[4];
#pragma unroll
    for (int i = 0; i < 8; ++i) {
        const int j = r8 + i; const f2 bb = off + bl[i];
        const f2 k = (f2){1.f - __expf(g[i].x), 1.f - __expf(g[i].y)};
        const f2 e1 = (f2){__expf(fminf(fmaxf(bb.x - bmid.x, -80.f), 80.f)), __expf(fminf(fmaxf(bb.y - bmid.y, -80.f), 80.f))};
        const f2 qt_ = q[i] * e1, kt_ = k * (f2){__builtin_amdgcn_rcpf(e1.x), __builtin_amdgcn_rcpf(e1.y)};
        const f2 qh = qt_ * cmid, kh_ = kt_ * cend;
        *(LAS unsigned*)(RG + j * 128 + d2) = pk2(qh.x, qh.y);
        *(LAS unsigned*)(Qt + j * HQ_LD + d2) = pk2(qt_.x, qt_.y);
        *(LAS unsigned*)(Kt + j * HQ_LD + d2) = pk2(kt_.x, kt_.y);
        const unsigned kk = pk2(kh_.x, kh_.y);
        if (i & 1) { k0[i >> 1] |= kk << 16; k1[i >> 1] |= kk & 0xffff0000u; } else { k0[i >> 1] = kk & 0xffffu; k1[i >> 1] = kk >> 16; }
    }
    *(LAS v4u*)(KhT + d2 * HK_LD + r8) = (v4u){k0[0], k0[1], k0[2], k0[3]};
    *(LAS v4u*)(KhT + (d2 + 1) * HK_LD + r8) = (v4u){k1[0], k1[1], k1[2], k1[3]};
    if (wave == 0) *(f2*)(DEC + (size_t)unit * 128 + d2) = (f2){__expf(bend.x), __expf(bend.y)};
    LBAR();
    if (lat) {
#pragma unroll
        for (int i = 0; i < 2; ++i) { const int p = tid + 512 * i, j = p >> 4, ch = p & 15; *(v4u*)(G + (rowb + (dir ? 63 - j : j)) * 512 + h * 128 + ch * 8) = *(const LAS v4u*)(RG + p * 8); }
    }
    {
        const int jb = wave >> 1;
#pragma unroll
        for (int sbi = 0; sbi < 2; ++sbi) {
            const int sb = 2 * (wave & 1) + sbi;
            f32x4 acc = (f32x4){0.f, 0.f, 0.f, 0.f};
#pragma unroll
            for (int ks = 0; ks < 4; ++ks) {
                const bf16x8_t af = *(const LAS bf16x8_t*)(Qt + (16 * jb + ln) * HQ_LD + 32 * ks + 8 * lg);
                const bf16x8_t bf = *(const LAS bf16x8_t*)(Kt + (16 * sb + ln) * HQ_LD + 32 * ks + 8 * lg);
                acc = __builtin_amdgcn_mfma_f32_16x16x32_bf16(af, bf, acc, 0, 0, 0);
            }
#pragma unroll
            for (int rg2 = 0; rg2 < 4; ++rg2) { const int j = 16 * jb + 4 * lg + rg2, sidx = 16 * sb + ln; Am[j * HK_LD + sidx] = f2bf(sidx <= j ? acc[rg2] : 0.f); }
        }
    }
    LBAR();
    {
        const int vb = wave;
        bf16x8_t vf[2];
#pragma unroll
        for (int ks = 0; ks < 2; ++ks) vf[ks] = *(const LAS bf16x8_t*)(VT + (16 * vb + ln) * HK_LD + 32 * ks + 8 * lg);
        if (lat) {
            LAS bf16_t* stg = (LAS bf16_t*)(lds + HA_QT + wave * 2048);
#pragma unroll
            for (int jb = 0; jb < 4; ++jb) {
                f32x4 acc = (f32x4){0.f, 0.f, 0.f, 0.f};
#pragma unroll
                for (int ks = 0; ks < 2; ++ks) { const bf16x8_t af = *(const LAS bf16x8_t*)(Am + (16 * jb + ln) * HK_LD + 32 * ks + 8 * lg); acc = __builtin_amdgcn_mfma_f32_16x16x32_bf16(af, vf[ks], acc, 0, 0, 0); }
#pragma unroll
                for (int rg2 = 0; rg2 < 4; ++rg2) stg[(16 * jb + 4 * lg + rg2) * 16 + ln] = f2bf(acc[rg2]);
            }
        }
        LAS unsigned char* ust = (LAS unsigned char*)(lds + HA_RAWQ + wave * 2048);
#pragma unroll
        for (int db = 0; db < 8; ++db) {
            f32x4 acc = (f32x4){0.f, 0.f, 0.f, 0.f};
#pragma unroll
            for (int ks = 0; ks < 2; ++ks) { const bf16x8_t bf = *(const LAS bf16x8_t*)(KhT + (16 * db + ln) * HK_LD + 32 * ks + 8 * lg); acc = __builtin_amdgcn_mfma_f32_16x16x32_bf16(bf, vf[ks], acc, 0, 0, 0); }
            *(LAS unsigned*)(ust + ln * 128 + 16 * db + 4 * lg) = pack4_fp8(acc[0], acc[1], acc[2], acc[3]);
        }
    }
    asm volatile("s_waitcnt lgkmcnt(0)" ::: "memory");
    {
        const int vb = wave;
        if (lat) {
            const LAS bf16_t* stg = (const LAS bf16_t*)(lds + HA_QT + wave * 2048);
#pragma unroll
            for (int i = 0; i < 2; ++i) { const int qq = lane + 64 * i, j = qq >> 1, hf = qq & 1; const size_t tok = (size_t)b * SEQ + 64 * (c - 4) + (dir ? 63 - j : j);
                *(v4u*)(OR + tok * 512 + h * 128 + 16 * vb + 8 * hf) = *(const LAS v4u*)(stg + j * 16 + 8 * hf); }
        }
        const LAS unsigned char* ust = (const LAS unsigned char*)(lds + HA_RAWQ + wave * 2048);
        unsigned char* ut = (unsigned char*)UT + (size_t)unit * 16384 + (size_t)(16 * vb) * 128;
#pragma unroll
        for (int i = 0; i < 2; ++i) { const int qq = lane + 64 * i, r = qq >> 3, ch = qq & 7; *(v4u*)(ut + r * 128 + ch * 16) = *(const LAS v4u*)(ust + r * 128 + ch * 16); }
    }
    LBAR();
}
__device__ __forceinline__ int hb_chunk(int dir, int st) { return dir == 0 ? st : (st < 4 ? 3 - st : 71 - st); }
__device__ __forceinline__ void hgrn_scan(int gw, bf16_t* UT, const float* __restrict__ DEC, int lane) {
    const int chain = gw >> 5, slice = gw & 31, dir = chain & 1, ubase = chain * NCHUNK;
    unsigned char* U8 = (unsigned char*)UT;
    const size_t eoff = (size_t)(4 * slice + (lane >> 4)) * 128 + 8 * (lane & 15);
    const int doff = 8 * (lane & 15);
    float S[8];
#pragma unroll
    for (int i = 0; i < 8; ++i) S[i] = 0.f;
    for (int st = 0; st < NCHUNK; st += 4) {
        v2u u[4]; f32x4 a[4][2];
#pragma unroll
        for (int k = 0; k < 4; ++k) { const int c = hb_chunk(dir, st + k); u[k] = *(const v2u*)(U8 + (size_t)(ubase + c) * 16384 + eoff); a[k][0] = *(const f32x4*)(DEC + (size_t)(ubase + c) * 128 + doff); a[k][1] = *(const f32x4*)(DEC + (size_t)(ubase + c) * 128 + doff + 4); }
#pragma unroll
        for (int k = 0; k < 4; ++k) {
            const int c = hb_chunk(dir, st + k);
            float u0[4], u1[4]; unpack4_fp8(u[k].x, u0); unpack4_fp8(u[k].y, u1);
#pragma unroll
            for (int p = 0; p < 4; ++p) { S[p] = a[k][0][p] * S[p] + u0[p]; S[4 + p] = a[k][1][p] * S[4 + p] + u1[p]; }
            v2u o; o.x = pack4_fp8(S[0], S[1], S[2], S[3]); o.y = pack4_fp8(S[4], S[5], S[6], S[7]);
            *(v2u*)(U8 + (size_t)(ubase + c) * 16384 + eoff) = o;
        }
    }
}
constexpr int HC_IS = 0, HC_RED = 16384, HC_RSTD = 18432, HC_QF = 20480, HC_QB = HC_QF + 64 * HQ_LD * 2, HC_END = HC_QB + 64 * HQ_LD * 2;
static_assert(HC_END <= 131072, "phase C LDS");
struct HcPre { v4u inf[2], inb[2], gr[2], qf[2], qb[2]; v2u sf[2][4]; };
__device__ __forceinline__ void hgrn_c_load(HcPre& P, int uid, const bf16_t* __restrict__ QF, const bf16_t* __restrict__ QB, const bf16_t* ORF, const bf16_t* __restrict__ ORB, const bf16_t* __restrict__ UT, const bf16_t* __restrict__ GR, int tid) {
    const int c = 4 + (uid & 63), h = (uid >> 6) & 3, b = uid >> 8;
    const int lane = tid & 63, vb = tid >> 6, ln = lane & 15, lg = lane >> 4;
    const size_t rowb = (size_t)b * TPB + 64 * c, tokb = (size_t)b * SEQ + 64 * (c - 4);
    const int usf = ((b * 4 + h) * 2 + 0) * NCHUNK + (c - 1), usb = ((b * 4 + h) * 2 + 1) * NCHUNK + (c == NCHUNK - 1 ? 0 : c + 1);
#pragma unroll
    for (int i = 0; i < 2; ++i) {
        const int p = tid + 512 * i, t = p >> 4, ch = p & 15; const size_t off = (tokb + t) * 512 + h * 128 + ch * 8, qoff = (rowb + t) * 512 + h * 128 + ch * 8;
        P.inf[i] = __builtin_nontemporal_load((const v4u*)(ORF + off)); P.inb[i] = __builtin_nontemporal_load((const v4u*)(ORB + off)); P.gr[i] = __builtin_nontemporal_load((const v4u*)(GR + off)); P.qf[i] = __builtin_nontemporal_load((const v4u*)(QF + qoff)); P.qb[i] = __builtin_nontemporal_load((const v4u*)(QB + qoff));
    }
#pragma unroll
    for (int ks = 0; ks < 4; ++ks) { P.sf[0][ks] = *(const v2u*)((const unsigned char*)UT + (size_t)usf * 16384 + (size_t)(16 * vb + ln) * 128 + 32 * ks + 8 * lg); P.sf[1][ks] = *(const v2u*)((const unsigned char*)UT + (size_t)usb * 16384 + (size_t)(16 * vb + ln) * 128 + 32 * ks + 8 * lg); }
}
__device__ __forceinline__ void hgrn_c_unit(int uid, int next_uid, HcPre& P, const bf16_t* __restrict__ QF, const bf16_t* __restrict__ QB, bf16_t* ORF, const bf16_t* __restrict__ ORB, const bf16_t* __restrict__ UT, const bf16_t* __restrict__ GR,
                                            const float* __restrict__ hg, LAS unsigned char* lds, int tid) {
    const int c = 4 + (uid & 63), h = (uid >> 6) & 3, b = uid >> 8;
    const int lane = tid & 63, vb = __builtin_amdgcn_readfirstlane(tid >> 6), ln = lane & 15, lg = lane >> 4;
    const size_t tokb = (size_t)b * SEQ + 64 * (c - 4);
    LAS bf16_t* IS = (LAS bf16_t*)(lds + HC_IS); LAS float* RED = (LAS float*)(lds + HC_RED); LAS float* RSTD = (LAS float*)(lds + HC_RSTD);
    LAS bf16_t* QFs = (LAS bf16_t*)(lds + HC_QF); LAS bf16_t* QBs = (LAS bf16_t*)(lds + HC_QB);
    v4u grv[2]; bf16x8_t sf[2][4];
#pragma unroll
    for (int i = 0; i < 2; ++i) {
        const int p = tid + 512 * i, t = p >> 4, ch = p & 15;
        const unsigned wf[4] = {P.inf[i].x, P.inf[i].y, P.inf[i].z, P.inf[i].w}, wq[4] = {P.inb[i].x, P.inb[i].y, P.inb[i].z, P.inb[i].w}; v4u o;
        o.x = pg8::cvt_pk_bf16(__uint_as_float(wf[0] << 16) + __uint_as_float(wq[0] << 16), __uint_as_float(wf[0] & 0xffff0000u) + __uint_as_float(wq[0] & 0xffff0000u));
        o.y = pg8::cvt_pk_bf16(__uint_as_float(wf[1] << 16) + __uint_as_float(wq[1] << 16), __uint_as_float(wf[1] & 0xffff0000u) + __uint_as_float(wq[1] & 0xffff0000u));
        o.z = pg8::cvt_pk_bf16(__uint_as_float(wf[2] << 16) + __uint_as_float(wq[2] << 16), __uint_as_float(wf[2] & 0xffff0000u) + __uint_as_float(wq[2] & 0xffff0000u));
        o.w = pg8::cvt_pk_bf16(__uint_as_float(wf[3] << 16) + __uint_as_float(wq[3] << 16), __uint_as_float(wf[3] & 0xffff0000u) + __uint_as_float(wq[3] & 0xffff0000u));
        *(LAS v4u*)(IS + p * 8) = o;
        *(LAS v4u*)(QFs + t * HQ_LD + ch * 8) = P.qf[i]; *(LAS v4u*)(QBs + t * HQ_LD + ch * 8) = P.qb[i];
        grv[i] = P.gr[i];
    }
#pragma unroll
    for (int ks = 0; ks < 4; ++ks)
#pragma unroll
        for (int dd = 0; dd < 2; ++dd) { float lo[4], hi[4]; unpack4_fp8(P.sf[dd][ks].x, lo); unpack4_fp8(P.sf[dd][ks].y, hi);
            v4u w; w.x = pk2(lo[0], lo[1]); w.y = pk2(lo[2], lo[3]); w.z = pk2(hi[0], hi[1]); w.w = pk2(hi[2], hi[3]); sf[dd][ks] = __builtin_bit_cast(bf16x8_t, w); }
    LBAR();
    if (next_uid >= 0) hgrn_c_load(P, next_uid, QF, QB, ORF, ORB, UT, GR, tid);
#pragma unroll
    for (int jb = 0; jb < 4; ++jb) {
        f32x4 acc;
#pragma unroll
        for (int rg = 0; rg < 4; ++rg) acc[rg] = bf2f(IS[(16 * jb + 4 * lg + rg) * 128 + 16 * vb + ln]);
#pragma unroll
        for (int ks = 0; ks < 4; ++ks) {
            acc = __builtin_amdgcn_mfma_f32_16x16x32_bf16(*(const LAS bf16x8_t*)(QFs + (16 * jb + ln) * HQ_LD + 32 * ks + 8 * lg), sf[0][ks], acc, 0, 0, 0);
            acc = __builtin_amdgcn_mfma_f32_16x16x32_bf16(*(const LAS bf16x8_t*)(QBs + (16 * jb + ln) * HQ_LD + 32 * ks + 8 * lg), sf[1][ks], acc, 0, 0, 0);
        }
#pragma unroll
        for (int rg = 0; rg < 4; ++rg) IS[(16 * jb + 4 * lg + rg) * 128 + 16 * vb + ln] = f2bf(acc[rg]);
    }
    LBAR();
    const f32x4 hg0 = *(const f32x4*)(hg + h * 128 + (tid & 15) * 8), hg1 = *(const f32x4*)(hg + h * 128 + (tid & 15) * 8 + 4);
#pragma unroll
    for (int i = 0; i < 2; ++i) {
        const int p = tid + 512 * i, t = p >> 4, ch = p & 15;
        const v4u sv = *(const LAS v4u*)(IS + p * 8);
        const unsigned ws_[4] = {sv.x, sv.y, sv.z, sv.w}, wg[4] = {grv[i].x, grv[i].y, grv[i].z, grv[i].w};
        float x[8]; float ss = 0.f;
#pragma unroll
        for (int q = 0; q < 4; ++q) { x[2 * q] = __uint_as_float(ws_[q] << 16); x[2 * q + 1] = __uint_as_float(ws_[q] & 0xffff0000u); ss += x[2 * q] * x[2 * q] + x[2 * q + 1] * x[2 * q + 1]; }
        ss += __shfl_xor(ss, 1); ss += __shfl_xor(ss, 2); ss += __shfl_xor(ss, 4); ss += __shfl_xor(ss, 8);
        const float rs = rsqrtf(ss * (1.f / 128.f) + EPS);
        v4u ov;
        ov.x = pk2(x[0] * rs * hg0[0] * __uint_as_float(wg[0] << 16), x[1] * rs * hg0[1] * __uint_as_float(wg[0] & 0xffff0000u));
        ov.y = pk2(x[2] * rs * hg0[2] * __uint_as_float(wg[1] << 16), x[3] * rs * hg0[3] * __uint_as_float(wg[1] & 0xffff0000u));
        ov.z = pk2(x[4] * rs * hg1[0] * __uint_as_float(wg[2] << 16), x[5] * rs * hg1[1] * __uint_as_float(wg[2] & 0xffff0000u));
        ov.w = pk2(x[6] * rs * hg1[2] * __uint_as_float(wg[3] << 16), x[7] * rs * hg1[3] * __uint_as_float(wg[3] & 0xffff0000u));
        *(v4u*)(ORF + (tokb + t) * 512 + h * 128 + ch * 8) = ov;
    }
    LBAR();
}

constexpr int CW_FLAG = 10240;
constexpr int CW_CNT = 8192;
__device__ __forceinline__ int build_tiles(const int* ctl, LAS int* segt, LAS int* tile_e, LAS int* cntl, int tid) {
    __syncthreads();
    if (tid < 64) {
        const int c = tid < 32 ? ctl[CW_CNT + 64 * tid] : 0, nt = (c + 255) >> 8;
        int p = nt;
#pragma unroll
        for (int o = 1; o < 32; o <<= 1) { const int t = __shfl_up(p, o); if (tid >= o) p += t; }
        const int start = p - nt;
        if (tid < 32) { segt[tid] = start; cntl[tid] = c; for (int i = 0; i < nt; ++i) tile_e[start + i] = tid; }
        if (tid == 31) segt[32] = p;
    }
    __syncthreads();
    return segt[32];
}

__global__ void __launch_bounds__(NWAVES * 64, 2) mk_fwd(Args a) {
    extern __shared__ __attribute__((aligned(16))) unsigned char lds[];
    cg::grid_group grid = cg::this_grid();
    const int tid = threadIdx.x, lane = tid & 63, wave = __builtin_amdgcn_readfirstlane(tid >> 6);
    const int G = gridDim.x, bx = blockIdx.x;
    unsigned char* ws = a.ws;
    const float* x = a.in[0]; const float* c = a.in[1]; const float* ctx = a.in[2]; const float* c_ctx = a.in[3];
    const float* w_ada = a.in[4]; const float* b_ada = a.in[5]; const float* norm1_g = a.in[6];
    const float* w_in = a.in[8]; const float* q_norm_g = a.in[9]; const float* k_norm_g = a.in[10];
    const float* hgrn_lb = a.in[12]; const float* w_out = a.in[14];
    const float* weg = a.in[19]; const float* weu = a.in[20]; const float* wed = a.in[21];
    float* mod = (float*)(ws + WS_MOD); float* lb = (float*)(ws + WS_MOD + 256 * 1024);
    bf16_t* WT_IN = (bf16_t*)(ws + WS_WTIN); bf16_t* WT_OUT = (bf16_t*)(ws + WS_WTOUT); bf16_t* WGU = (bf16_t*)((unsigned char*)a.out + OUT_WGU); bf16_t* WDN = (bf16_t*)((unsigned char*)a.out + OUT_WDN);
    bf16_t* DL = (bf16_t*)(ws + WS_DL);
    bf16_t* H = (bf16_t*)(ws + WS_H);

#if defined(TIME_A)
    if (TIME_A >= 0 && blockIdx.x == 0 && threadIdx.x == 0) ((volatile LAS unsigned long long*)(lds + MISC_OFF + 4608))[15] = __builtin_amdgcn_s_memrealtime();
#endif
    {
        LAS float* rt = (LAS float*)(lds + ROPE_OFF);
        for (int i = tid; i < 1024; i += NWAVES * 64) { const int pos = i >> 4, f = i & 15; const float ang = (float)pos * powf(10000.0f, -(float)f * (1.0f / 16.0f)); rt[2 * i] = cosf(ang); rt[2 * i + 1] = sinf(ang); }
    }
    const int ph_lo = a.ph_lo, ph_hi = a.ph_hi;
#ifndef TIME_A
#define TIME_A -1
#endif
#ifndef TIME_B
#define TIME_B 0
#endif
#define STAMP(i) do { if (TIME_A >= 0 && bx == 0 && tid == 0) ((volatile LAS unsigned long long*)(lds + MISC_OFF + 4608))[i] = __builtin_amdgcn_s_memrealtime(); } while (0)
    STAMP(0);
    if (ph_lo > 1000) grid.sync();
#define IN(k) (ph_lo <= (k) && (k) < ph_hi)
#define SEAM(k) do { if (IN(k) && IN((k) + 1)) { xcd_barrier(xbar); } } while (0)
    if (tid < 2) ((volatile LAS unsigned*)(lds + MISC_OFF + 4096))[tid] = 0u;
    __syncthreads();
    XcdBarrier xbar = xcd_barrier_post((unsigned*)(ws + WS_CTL) + 4096, (volatile LAS unsigned*)(lds + MISC_OFF + 4096));
    if (IN(0)) {
        PHASE_IDS
    if (bx < 192) {
        LAS float* s = (LAS float*)lds; LAS float* part = (LAS float*)(lds + 40960);
        for (int i = tid; i < 9 * 1024; i += NWAVES * 64) { const int r = i >> 10, k = i & 1023; const float v = r < 8 ? c[r * 1024 + k] : c_ctx[k]; s[i] = v / (1.f + expf(-v)); }
        __syncthreads();
        const int j = tid & 31, ks = tid >> 5, j0 = bx * 32;
        float acc[9];
#pragma unroll
        for (int r = 0; r < 9; ++r) acc[r] = 0.f;
#pragma unroll
        for (int kb = 0; kb < 2; ++kb) {
            float w[32];
#pragma unroll
            for (int kk = 0; kk < 32; ++kk) w[kk] = __builtin_nontemporal_load(w_ada + (size_t)(ks * 64 + kb * 32 + kk) * 6144 + j0 + j);
#pragma unroll
            for (int kk = 0; kk < 32; ++kk) { const int k = ks * 64 + kb * 32 + kk;
#pragma unroll
                for (int r = 0; r < 9; ++r) acc[r] += s[r * 1024 + k] * w[kk]; }
        }
#pragma unroll
        for (int r = 0; r < 9; ++r) part[(ks * 9 + r) * 32 + j] = acc[r];
        __syncthreads();
        if (tid < 288) { const int r = tid >> 5, jj = tid & 31; float sum = b_ada[j0 + jj];
            for (int q = 0; q < 16; ++q) sum += part[(q * 9 + r) * 32 + jj];
            mod[r * 6144 + j0 + jj] = sum; }
    }
    if (bx >= 192 && bx < G - 1) {
        const int nw = (G - 1 - 192) * NWAVES, wi = (bx - 192) * NWAVES + wave;
        const f32x4* xp = (const f32x4*)x;
        constexpr size_t NPF = (size_t)NLAT * D / 4 * 4 / 8;
        for (size_t p = (size_t)wi * 64 + lane; p < NPF; p += (size_t)nw * 64 * 8) {
            f32x4 t[8];
#pragma unroll
            for (int q = 0; q < 8; ++q) { const size_t pp = p + (size_t)q * nw * 64; t[q] = pp < NPF ? xp[pp] : (f32x4){0.f, 0.f, 0.f, 0.f}; }
#pragma unroll
            for (int q = 0; q < 8; ++q) asm volatile("" :: "v"(t[q]));
        }
    }
    if (bx == G - 1) {
        for (int i = tid; i < 1024; i += NWAVES * 64) { const int d = i >> 9, w = i & 511; const float l0 = hgrn_lb[(d * 2 + 0) * 512 + w], l1 = hgrn_lb[(d * 2 + 1) * 512 + w]; lb[i] = 1.f / (1.f + expf(l1 - l0)); }
        bf16_t* WRT = (bf16_t*)(ws + WS_WRT);
        for (int i = tid; i < 48 * 1024; i += NWAVES * 64) { const int n = i >> 10, k = i & 1023; const float v = n < 4 ? a.in[15][k * 4 + n] : (n < 36 ? a.in[17][k * 32 + (n - 4)] : 0.f); WRT[i] = f2bf(v); }
    }
    __syncthreads();
    {
        LAS float* scr = (LAS float*)(lds + RING_OFF + wave * 16384);
        const int gw = bx * NWAVES + wave, NGW = G * NWAVES;
        constexpr int I_IN = 16 * 104, I_OUT = 16 * 32;
        for (int it = gw; it < I_IN + I_OUT; it += NGW) {
            int r = it;
            if (r < I_IN) { const int kb = r / 104, nb = r % 104; tr_item(w_in, PW, 64 * kb, 32 * nb, WT_IN + (size_t)win_vc0(32 * nb) * 1024, 1024, scr, lane); continue; } r -= I_IN;
            { const int kb = r / 32, nb = r % 32; tr_item(w_out, 1024, 64 * kb, 32 * nb, WT_OUT + (size_t)(32 * nb) * 1024, 1024, scr, lane); }
        }
    }
    }
    SEAM(0);
    STAMP(1);
    if (IN(1)) {
        PHASE_IDS
        const int gw = bx * NWAVES + wave, NGW = G * NWAVES;
#define MOD_ROWS(NR, ROW0) do { const int row0_ = (ROW0), b_ = row0_ / TPB, pos_ = row0_ % TPB; \
            const float* src_ = pos_ < CTX ? ctx + ((size_t)b_ * CTX + pos_) * D : x + ((size_t)b_ * SEQ + (pos_ - CTX)) * D; \
            const float* m_ = mod + (pos_ < CTX ? 8 : b_) * 6144; \
            f32x4 v_[NR][4], ga_[4], sh_[4]; \
            _Pragma("unroll") for (int r = 0; r < NR; ++r) _Pragma("unroll") for (int j = 0; j < 4; ++j) v_[r][j] = __builtin_nontemporal_load((const f32x4*)(src_ + (size_t)r * D + 512 * (j >> 1) + 8 * lane + 4 * (j & 1))); \
            _Pragma("unroll") for (int j = 0; j < 4; ++j) { const int k = 512 * (j >> 1) + 8 * lane + 4 * (j & 1); const f32x4 g = *(const f32x4*)(norm1_g + k), sc = *(const f32x4*)(m_ + 1024 + k); sh_[j] = *(const f32x4*)(m_ + k); ga_[j] = g * (1.f + sc); } \
            _Pragma("unroll") for (int r = 0; r < NR; ++r) { float ss = 0.f; \
                _Pragma("unroll") for (int j = 0; j < 4; ++j) ss += (v_[r][j][0] * v_[r][j][0] + v_[r][j][1] * v_[r][j][1]) + (v_[r][j][2] * v_[r][j][2] + v_[r][j][3] * v_[r][j][3]); \
                const float rstd = rsqrtf(wave_sum(ss) * (1.f / D) + EPS); \
                _Pragma("unroll") for (int hh = 0; hh < 2; ++hh) { const f32x4 o0 = v_[r][2 * hh] * rstd * ga_[2 * hh] + sh_[2 * hh], o1 = v_[r][2 * hh + 1] * rstd * ga_[2 * hh + 1] + sh_[2 * hh + 1]; \
                    v4u pk; pk.x = pk2(o0[0], o0[1]); pk.y = pk2(o0[2], o0[3]); pk.z = pk2(o1[0], o1[1]); pk.w = pk2(o1[2], o1[3]); \
                    *(v4u*)(H + (size_t)(row0_ + r) * D + 512 * hh + 8 * lane) = pk; } } } while (0)
        for (int i = 0; i < 4; ++i) { const int grp = gw + i * NGW; if (4 * grp + 3 < NROW) MOD_ROWS(4, 4 * grp); }
        for (int row = 16 * NGW + gw; row < NROW; row += NGW) MOD_ROWS(1, row);
#undef MOD_ROWS
    }
    SEAM(1);
    STAMP(2);
    if (IN(2)) {
        PHASE_IDS
        pg8::Gemm g{H, WT_IN, NROW, PW, D}; pg8::StaticOrder S; S.init(NROW, PW, G, bx);
        LAS float* etab = (LAS float*)(lds + XTRA_OFF);
        for (int i = tid; i < 1152; i += NWAVES * 64) etab[i] = i < 64 ? q_norm_g[i] : (i < 128 ? k_norm_g[i - 64] : lb[i - 128]);
        __syncthreads();
        pg8::EpiInproj E{(bf16_t*)(ws + WS_QA), (bf16_t*)(ws + WS_KA), (bf16_t*)(ws + WS_VA), (bf16_t*)(ws + WS_QR), (bf16_t*)(ws + WS_GF), (bf16_t*)(ws + WS_GB),
                         (bf16_t*)(ws + WS_IV), (bf16_t*)(ws + WS_GR), etab, etab + 64, etab + 128, (const LAS pg8::f32x2*)(lds + ROPE_OFF)};
        pg8::gemm_phase<pg8::EpiInproj, pg8::StaticOrder, true, true>((LAS unsigned char*)lds + RING_OFF, g, S, E);
    }
#ifdef EXP_NULLEPI
    if (IN(2)) {
        xcd_barrier(xbar);
        pg8::Gemm g{H, WT_IN, NROW, PW, D}; pg8::StaticOrder S; S.init(NROW, PW, G, bx);
        pg8::EpiNull E{};
        pg8::gemm_phase<pg8::EpiNull, pg8::StaticOrder, true, true>((LAS unsigned char*)lds + RING_OFF, g, S, E);
    }
#endif
    SEAM(2);
    STAMP(3);
    if (IN(3)) {
        PHASE_IDS
        static_assert(attn_body::ATTN_LDS_BYTES <= RING_BYTES, "attention LDS");
        const attn_body::AttnTensors AT{(const attn_body::bf16*)(ws + WS_QA), (const attn_body::bf16*)(ws + WS_KA), (const attn_body::bf16*)(ws + WS_VA), (attn_body::bf16*)(ws + WS_QA), a.in[11]};
        const attn_body::StaticOrder S(G, bx);
        const bool hfirst = ((bx >> 3) & 1) != 0;
#define HGRN_A_UNITS() do { __syncthreads(); v4u rg_[6]; if (bx < NHUNIT) hgrn_a_load(rg_, bx, (const bf16_t*)(ws + WS_QR), (const bf16_t*)(ws + WS_GF), (const bf16_t*)(ws + WS_GB), (const bf16_t*)(ws + WS_IV), tid); \
        for (int unit = bx; unit < NHUNIT; unit += G) \
            hgrn_a_unit(unit, unit + G < NHUNIT ? unit + G : -1, rg_, (const bf16_t*)(ws + WS_QR), (bf16_t*)(ws + WS_GF), (bf16_t*)(ws + WS_GB), (const bf16_t*)(ws + WS_IV), (bf16_t*)(ws + WS_ORF), (bf16_t*)(ws + WS_ORB), \
                        (bf16_t*)(ws + WS_UT), (float*)(ws + WS_DEC), (LAS unsigned char*)lds + RING_OFF, (LAS float*)(lds + ROPE_OFF), tid); } while (0)
#define TR_CHUNK(ci) do { if ((ci) < 3) { __syncthreads(); { const int gw = bx * NWAVES + wave, NGW = G * NWAVES; \
            LAS float* scr = (LAS float*)(lds + RING_OFF + wave * 16640); \
            constexpr int NIT = 3 * 32 * 128; \
            f32x4 va[16], vb2[16]; const int it0 = gw + 2 * (ci) * NGW, it1 = it0 + NGW; \
            const TrDesc da = tr_expert_desc(it0 < NIT ? it0 : 0, weg, weu, wed, WGU, WDN), db = tr_expert_desc(it1 < NIT ? it1 : 0, weg, weu, wed, WGU, WDN); \
            if (it0 < NIT) tr_load64(va, da, lane); if (it1 < NIT) tr_load64(vb2, db, lane); \
            if (it0 < NIT) tr_finish64(va, da, scr, lane); if (it1 < NIT) tr_finish64(vb2, db, scr, lane); \
        } __syncthreads(); } } while (0)
        if (hfirst) HGRN_A_UNITS();
        {
            struct TrSched {
                attn_body::StaticOrder S; bool first; const float *weg, *weu, *wed; bf16_t *WGU, *WDN; unsigned char* lds;
                __device__ __forceinline__ bool next(int i, attn_body::AttnUnit& u) const { return S.next(i, u); }
                __device__ __forceinline__ void chunk(int ci) const { const int tid_ = fresh_tid(), lane = tid_ & 63, wave = __builtin_amdgcn_readfirstlane(tid_ >> 6), bx = blockIdx.x, G = gridDim.x; TR_CHUNK(ci); }
                __device__ __forceinline__ void a_ready(const attn_body::AttnUnit& u) const { if (first) chunk((((u.bh & 7) << 4 | u.qb) >> 5)); }
                __device__ __forceinline__ void done(const attn_body::AttnUnit& u) const { if (!first) chunk((((u.bh & 7) << 4 | u.qb) >> 5)); }
            };
            const TrSched TS{S, hfirst, weg, weu, wed, WGU, WDN, lds};
            attn_body::attn_phase<TrSched>((char*)lds + RING_OFF, AT, TS);
        }
        STAMP(4);
        if (!hfirst) HGRN_A_UNITS();
#undef HGRN_A_UNITS
#undef TR_CHUNK
    }
    SEAM(3);
    STAMP(5);
    if (IN(4)) {
        PHASE_IDS
        const int vcu = (G % 8 == 0) ? (bx % 8) * (G / 8) + bx / 8 : bx;
        for (int gw = vcu * NWAVES + wave; gw < 64 * 32; gw += G * NWAVES) hgrn_scan(gw, (bf16_t*)(ws + WS_UT), (const float*)(ws + WS_DEC), lane);
    }
    SEAM(4);
    STAMP(6);
    if (IN(5)) {
        PHASE_IDS
        const int vcu = (G % 8 == 0) ? (bx % 8) * (G / 8) + bx / 8 : bx;
        __syncthreads();
        HcPre hp;
        if (vcu < NB * 4 * 64) hgrn_c_load(hp, vcu, (const bf16_t*)(ws + WS_GF), (const bf16_t*)(ws + WS_GB), (const bf16_t*)(ws + WS_ORF), (const bf16_t*)(ws + WS_ORB), (const bf16_t*)(ws + WS_UT), (const bf16_t*)(ws + WS_GR), tid);
        for (int uid = vcu; uid < NB * 4 * 64; uid += G)
            hgrn_c_unit(uid, uid + G < NB * 4 * 64 ? uid + G : -1, hp, (const bf16_t*)(ws + WS_GF), (const bf16_t*)(ws + WS_GB), (bf16_t*)(ws + WS_ORF), (const bf16_t*)(ws + WS_ORB), (const bf16_t*)(ws + WS_UT), (const bf16_t*)(ws + WS_GR), a.in[13],
                        (LAS unsigned char*)lds + RING_OFF, tid);
    }
    SEAM(5);
    STAMP(7);
    if (IN(6)) {
        PHASE_IDS
        pg8::Gemm g{(const bf16_t*)(ws + WS_QA), WT_OUT, NLAT, D, D, 512, 8, (long)(WS_ORF - WS_QA) - 8 * 128}; pg8::StaticOrder S; S.init(NLAT, D, G, bx);
        pg8::EpiOutproj E{mod, DL};
        pg8::gemm_phase<pg8::EpiOutproj, pg8::StaticOrder, true, true>((LAS unsigned char*)lds + RING_OFF, g, S, E);
    }
    SEAM(6);
    STAMP(8);
    LAS int* segt = (LAS int*)(lds + MISC_OFF); LAS int* tile_e = (LAS int*)(lds + MISC_OFF + 256); LAS int* cntl = (LAS int*)(lds + MISC_OFF + 2048);
    int* ctl = (int*)(ws + WS_CTL);
    float* ew = (float*)(ws + WS_RT); int* list = (int*)(ws + WS_LIST);
    bf16_t* H2 = (bf16_t*)(ws + WS_H2M); bf16_t* ACT2 = (bf16_t*)(ws + WS_ACT2); bf16_t* YS2 = (bf16_t*)(ws + WS_YS2);
    if (IN(7)) {
        PHASE_IDS
        const float* norm2_g = a.in[7]; const float* brg = a.in[16]; const float* bre = a.in[18];
        const bf16_t* WRT = (const bf16_t*)(ws + WS_WRT);
        constexpr int HT_LD = 1032;
        LAS bf16_t* HT = (LAS bf16_t*)(lds);
        LAS float* PART = (LAS float*)(lds + 34816);
        LAS float* LG = (LAS float*)(lds + 34816 + 24576);
        LAS int* lhist = (LAS int*)(lds + 65536); LAS int* lbase = lhist + 32; LAS int* asg = lhist + 64;
        const int ln = lane & 15, lg4 = lane >> 4;
        for (int wg0 = ((G % 8 == 0) ? (bx % 8) * (G / 8) + bx / 8 : bx); wg0 < NLAT / 128; wg0 += G) {
            const int tokw = wg0 * 128; const float* m = mod + (tokw / SEQ) * 6144;
            if (tid < 32) lhist[tid] = 0;
            f32x4 ga[4], sh[4];
#pragma unroll
            for (int j = 0; j < 4; ++j) { const int k = 4 * lane + 256 * j; const f32x4 g = *(const f32x4*)(norm2_g + k), sc = *(const f32x4*)(m + 4096 + k); sh[j] = *(const f32x4*)(m + 3072 + k); ga[j] = g * (1.f + sc); }
            bf16x8_t wf[4][3];
#pragma unroll
            for (int ks = 0; ks < 4; ++ks)
#pragma unroll
                for (int nt = 0; nt < 3; ++nt) wf[ks][nt] = *(const bf16x8_t*)(WRT + (size_t)(16 * nt + ln) * D + 128 * wave + 32 * ks + 8 * lg4);
            f32x4 xv[2][4]; uint2 dv[2][4];
#pragma unroll
            for (int r = 0; r < 2; ++r)
#pragma unroll
                for (int j = 0; j < 4; ++j) { const size_t o_ = (size_t)(tokw + 2 * wave + r) * D + 4 * lane + 256 * j; xv[r][j] = __builtin_nontemporal_load((const f32x4*)(x + o_)); dv[r][j] = *(const uint2*)(DL + o_); }
            for (int t = 0; t < 8; ++t) {
                const int tok0 = tokw + 16 * t;
#pragma unroll
                for (int r = 0; r < 2; ++r) {
                    f32x4 v[4]; float ss = 0.f;
#pragma unroll
                    for (int j = 0; j < 4; ++j) { v[j] = (f32x4){xv[r][j][0] + __uint_as_float(dv[r][j].x << 16), xv[r][j][1] + __uint_as_float(dv[r][j].x & 0xffff0000u), xv[r][j][2] + __uint_as_float(dv[r][j].y << 16), xv[r][j][3] + __uint_as_float(dv[r][j].y & 0xffff0000u)};
                        ss += (v[j][0] * v[j][0] + v[j][1] * v[j][1]) + (v[j][2] * v[j][2] + v[j][3] * v[j][3]); }
                    const float rstd = rsqrtf(wave_sum(ss) * (1.f / D) + EPS);
#pragma unroll
                    for (int j = 0; j < 4; ++j) { const f32x4 o = v[j] * rstd * ga[j] + sh[j]; uint2 pk; pk.x = pk2(o[0], o[1]); pk.y = pk2(o[2], o[3]);
                        *(uint2*)(H2 + (size_t)(tok0 + 2 * wave + r) * D + 4 * lane + 256 * j) = pk; *(LAS v2u*)(HT + (2 * wave + r) * HT_LD + 4 * lane + 256 * j) = (v2u){pk.x, pk.y}; }
                }
                LBAR();
                if (t + 1 < 8) {
#pragma unroll
                    for (int r = 0; r < 2; ++r)
#pragma unroll
                        for (int j = 0; j < 4; ++j) { const size_t o_ = (size_t)(tok0 + 16 + 2 * wave + r) * D + 4 * lane + 256 * j; xv[r][j] = __builtin_nontemporal_load((const f32x4*)(x + o_)); dv[r][j] = *(const uint2*)(DL + o_); }
                }
                f32x4 acc[3];
#pragma unroll
                for (int nt = 0; nt < 3; ++nt) acc[nt] = (f32x4){0.f, 0.f, 0.f, 0.f};
#pragma unroll
                for (int ks = 0; ks < 4; ++ks) {
                    const bf16x8_t af = *(const LAS bf16x8_t*)(HT + ln * HT_LD + 128 * wave + 32 * ks + 8 * lg4);
#pragma unroll
                    for (int nt = 0; nt < 3; ++nt) acc[nt] = __builtin_amdgcn_mfma_f32_16x16x32_bf16(af, wf[ks][nt], acc[nt], 0, 0, 0);
                }
#pragma unroll
                for (int nt = 0; nt < 3; ++nt)
#pragma unroll
                    for (int rg = 0; rg < 4; ++rg) PART[(wave * 16 + 4 * lg4 + rg) * 48 + 16 * nt + ln] = acc[nt][rg];
                LBAR();
                for (int p = tid; p < 16 * 36; p += NWAVES * 64) { const int row = p / 36, n = p % 36; float sacc = 0.f;
#pragma unroll
                    for (int w = 0; w < 8; ++w) sacc += PART[(w * 16 + row) * 48 + n];
                    LG[row * 48 + n] = sacc; }
                LBAR();
                if (tid < 16) {
                    const LAS float* l = LG + tid * 48; const int tok = tok0 + tid;
                    float lgp[4]; int gs = 0; float gm = -1e30f;
#pragma unroll
                    for (int g = 0; g < 4; ++g) { lgp[g] = l[g] + brg[g]; if (lgp[g] > gm) { gm = lgp[g]; gs = g; } }
                    float z = 0.f;
#pragma unroll
                    for (int g = 0; g < 4; ++g) z += __expf(lgp[g] - gm);
                    const float pg = 1.f / z;
                    int e1 = 0, e2 = 0; float m1 = -1e30f, m2 = -1e30f;
                    for (int j = 0; j < 8; ++j) { const float v = l[4 + gs * 8 + j] + bre[gs * 8 + j]; if (v > m1) { m2 = m1; e2 = e1; m1 = v; e1 = j; } else if (v > m2) { m2 = v; e2 = j; } }
                    const float rr = __expf(m2 - m1);
                    const int E1 = gs * 8 + e1, E2 = gs * 8 + e2;
                    ew[tok * 2] = pg / (1.f + rr); ew[tok * 2 + 1] = pg * rr / (1.f + rr);
                    const int r1 = __hip_atomic_fetch_add(lhist + E1, 1, __ATOMIC_RELAXED, __HIP_MEMORY_SCOPE_WORKGROUP), r2 = __hip_atomic_fetch_add(lhist + E2, 1, __ATOMIC_RELAXED, __HIP_MEMORY_SCOPE_WORKGROUP);
                    asg[(16 * t + tid) * 2] = (E1 << 16) | r1; asg[(16 * t + tid) * 2 + 1] = (E2 << 16) | r2;
                }
            }
            LBAR();
            if (tid < 32) { const int n = lhist[tid]; lbase[tid] = n ? atomicAdd(&ctl[CW_CNT + 64 * tid], n) : 0; }
            LBAR();
            if (tid < 256) { const int e_ = asg[tid] >> 16, r_ = asg[tid] & 0xffff; list[e_ * LISTCAP + lbase[e_] + r_] = (tokw + (tid >> 1)) * 2 + (tid & 1); }
            LBAR();
        }
    }
    SEAM(7);
    STAMP(9);
    STAMP(10);
    if (IN(9)) {
        PHASE_IDS
        const int ntl = build_tiles(ctl, segt, tile_e, cntl, tid);
        LAS int* rowtab = (LAS int*)(lds + ROPE_OFF);
        const int cu = (G % 8 == 0) ? (bx % 8) * (G / 8) + bx / 8 : bx;
        const int U = ntl * 4, n5 = min(max(U - 4 * G, 0), G);
        unsigned* flags = (unsigned*)ctl + CW_FLAG;
        for (int i = 0; i * G + cu < U && i < 8; ++i) {
            const int ti = (i * G + cu) >> 2, e = tile_e[ti], r0 = (ti - segt[e]) * 256;
            if (tid < 256) rowtab[i * 256 + tid] = (r0 + tid < cntl[e]) ? (list[e * LISTCAP + r0 + tid] >> 1) : 0;
        }
        pg8::MoeConsSched S2{tile_e, U, G, cu, n5, (size_t)1024 * 512 * 2, flags};
        LAS int* ridx = (LAS int*)(lds + XTRA_OFF); LAS float* rw = (LAS float*)(lds + XTRA_OFF + 8192);
        for (int i = 0; i < 8; ++i) {
            const int q = S2.q_of(i); if (q >= U) break;
            const int ti = q >> 2, e = tile_e[ti], r0 = (ti - segt[e]) * 256;
            if (tid < 256) { const bool ok = r0 + tid < cntl[e]; const int idx = ok ? list[e * LISTCAP + r0 + tid] : -1; ridx[i * 256 + tid] = idx; rw[i * 256 + tid] = ok ? ew[idx] : 0.f; }
        }
        __syncthreads();
        {
            pg8::Gemm g{H2, WGU, 0, 0, D}; pg8::MoeProdSched S{tile_e, U, G, cu, (size_t)1024 * 1024 * 2, rowtab, flags};
            pg8::EpiMoe1 E{ACT2};
            pg8::gemm_phase<pg8::EpiMoe1, pg8::MoeProdSched, true, true>((LAS unsigned char*)lds + RING_OFF, g, S, E);
        }
        STAMP(11);
        {
            pg8::Unit u0;
            if (S2.next(0, u0)) { if (tid == 0) S2.wait_tile(u0.pm); }
            asm volatile("s_waitcnt vmcnt(0)" ::: "memory");
            __syncthreads();
            pg8::Gemm g{ACT2, WDN, 0, 0, FFE};
            pg8::EpiMoe2 E{YS2, ridx, rw};
            pg8::gemm_phase<pg8::EpiMoe2, pg8::MoeConsSched, true, true>((LAS unsigned char*)lds + RING_OFF, g, S2, E);
        }
    }
    SEAM(10);
    STAMP(12);
    if (IN(11)) {
        PHASE_IDS
        const int gw = bx * NWAVES + wave, NGW = G * NWAVES;
        const unsigned char* YS8 = (const unsigned char*)YS2;
        for (int grp = gw; grp < NLAT / 2; grp += NGW) {
            const float* m = mod + ((2 * grp) / SEQ) * 6144 + 5120 + 16 * lane;
            f32x4 xv[2][4], gt[4]; v4u dv[2][2], p[2], q[2];
#pragma unroll
            for (int r = 0; r < 2; ++r) { const size_t tok = 2 * grp + r;
#pragma unroll
                for (int j = 0; j < 4; ++j) xv[r][j] = *(const f32x4*)(x + tok * D + 16 * lane + 4 * j);
                dv[r][0] = *(const v4u*)(DL + tok * D + 16 * lane); dv[r][1] = *(const v4u*)(DL + tok * D + 16 * lane + 8);
                p[r] = *(const v4u*)(YS8 + (2 * tok) * D + 16 * lane); q[r] = *(const v4u*)(YS8 + (2 * tok + 1) * D + 16 * lane); }
#pragma unroll
            for (int j = 0; j < 4; ++j) gt[j] = *(const f32x4*)(m + 4 * j);
#pragma unroll
            for (int r = 0; r < 2; ++r) {
                const unsigned pw[4] = {p[r].x, p[r].y, p[r].z, p[r].w}, qw[4] = {q[r].x, q[r].y, q[r].z, q[r].w};
                const unsigned dw[8] = {dv[r][0].x, dv[r][0].y, dv[r][0].z, dv[r][0].w, dv[r][1].x, dv[r][1].y, dv[r][1].z, dv[r][1].w};
#pragma unroll
                for (int j = 0; j < 4; ++j) {
                    float y0[4], y1[4]; unpack4_fp8(pw[j], y0); unpack4_fp8(qw[j], y1);
                    f32x4 o;
                    o[0] = xv[r][j][0] + __uint_as_float(dw[2 * j] << 16) + gt[j][0] * (y0[0] + y1[0]);
                    o[1] = xv[r][j][1] + __uint_as_float(dw[2 * j] & 0xffff0000u) + gt[j][1] * (y0[1] + y1[1]);
                    o[2] = xv[r][j][2] + __uint_as_float(dw[2 * j + 1] << 16) + gt[j][2] * (y0[2] + y1[2]);
                    o[3] = xv[r][j][3] + __uint_as_float(dw[2 * j + 1] & 0xffff0000u) + gt[j][3] * (y0[3] + y1[3]);
                    *(f32x4*)(a.out + (size_t)(2 * grp + r) * D + 16 * lane + 4 * j) = o;
                }
            }
        }
    }
    STAMP(13);
    if (TIME_A >= 0 && bx == 0 && tid == 0) {
        volatile LAS unsigned long long* tsl = (volatile LAS unsigned long long*)(lds + MISC_OFF + 4608);
        const unsigned long long dl = (tsl[TIME_B] - tsl[TIME_A]) * 4ull, t0 = __builtin_amdgcn_s_memrealtime();
        while (__builtin_amdgcn_s_memrealtime() - t0 < dl) __builtin_amdgcn_s_sleep(8);
    }
#undef IN
#undef SEAM
}
extern "C" void kernel_launch(void* const* d_in, const int* in_sizes, int n_in, void* d_out, int out_size, void* d_ws, size_t ws_size, hipStream_t stream) {
    static int grid = 0;
    if (grid == 0) {
        if (n_in != 22 || ws_size < WS_END) { fprintf(stderr, "kernel_launch: unexpected n_in %d / ws_size %zu\n", n_in, ws_size); grid = -1; return; }
        int dev = 0, cus = 0, per_cu = 0;
        if (hipGetDevice(&dev) != hipSuccess || hipDeviceGetAttribute(&cus, hipDeviceAttributeMultiprocessorCount, dev) != hipSuccess) { grid = -1; return; }
        if (hipFuncSetAttribute((const void*)mk_fwd, hipFuncAttributeMaxDynamicSharedMemorySize, LDS_BYTES) != hipSuccess) { fprintf(stderr, "kernel_launch: hipFuncSetAttribute failed\n"); grid = -1; return; }
        if (hipOccupancyMaxActiveBlocksPerMultiprocessor(&per_cu, (const void*)mk_fwd, NWAVES * 64, LDS_BYTES) != hipSuccess || per_cu < 1) { fprintf(stderr, "kernel_launch: occupancy query says %d\n", per_cu); per_cu = 1; }
        (void)hipGetLastError();
        grid = cus;
        fprintf(stderr, "kernel_launch: cus %d per_cu %d grid %d\n", cus, per_cu, grid);
    }
    if (grid < 0) return;
    float* out = (float*)d_out;
    unsigned char* ws = (unsigned char*)d_ws;
    int* ctl = (int*)(ws + WS_CTL);
    (void)hipMemsetAsync(ctl, 0, 64 * 1024, stream);
    Args a{};
    for (int i = 0; i < 22; ++i) a.in[i] = (const float*)d_in[i];
    a.out = out; a.ws = ws;
    void* kargs[] = {&a};
    a.ph_lo = 0; a.ph_hi = 12;
    hipError_t le = hipLaunchCooperativeKernel((const void*)mk_fwd, dim3(grid), dim3(NWAVES * 64), kargs, LDS_BYTES, stream);
    if (le != hipSuccess) fprintf(stderr, "kernel_launch: cooperative launch failed: %s\n", hipGetErrorString(le));
}
```
